# Optimizing an MI355X kernel written in HIP

```python
import math
import jax, jax.numpy as jnp
from jax import lax
import numpy as np

D_MODEL = 1024
BATCH = 4
SEQ = 8192
DEPTH = 2

D_MIX = D_MODEL
ATT_HEADS = 8
ATT_HD = 64
D_ATT = ATT_HEADS * ATT_HD
D_CONV = 256
CONV_GROUPS = 4
CONV_K = 31
D_RNN = 256
RNN_BLOCKS = 4
RNN_BD = D_RNN // RNN_BLOCKS
RNN_CONV_K = 4
RG_C = 8.0
Q_BLOCK = 128
EPS = 1e-6

Q0, Q1 = 0, D_ATT
K0, K1 = Q1, Q1 + D_ATT
V0, V1 = K1, K1 + D_ATT
F0, F1 = V1, V1 + ATT_HEADS
C0, C1 = F1, F1 + 2 * D_CONV
R0, R1 = C1, C1 + D_RNN
G0, G1 = R1, R1 + D_RNN
N_IN = G1

PEER_HEADS = 8
N_KEYS = 128
N_EXPERTS = N_KEYS * N_KEYS
D_KEY = 256
D_HALF = D_KEY // 2
TOPK = 16
TOK_CHUNK = 128

kernel_name = "hymba_fox_conformer_rglru_peer"


def rms_norm(x, g):
    xf = x.astype(jnp.float32)
    y = xf * lax.rsqrt(jnp.mean(xf * xf, axis=-1, keepdims=True) + EPS)
    return (y * g.astype(jnp.float32)).astype(x.dtype)


def layer_norm(x, g, b):
    xf = x.astype(jnp.float32)
    mu = jnp.mean(xf, axis=-1, keepdims=True)
    var = jnp.mean(jnp.square(xf - mu), axis=-1, keepdims=True)
    y = (xf - mu) * lax.rsqrt(var + EPS)
    return (y * g.astype(jnp.float32) + b.astype(jnp.float32)).astype(x.dtype)


def causal_dwconv(x, w, b):
    k = w.shape[0]
    y = lax.conv_general_dilated(
        x, w[:, None, :], window_strides=(1,), padding=[(k - 1, 0)],
        dimension_numbers=("NWC", "WIO", "NWC"), feature_group_count=x.shape[-1])
    return y + b


def forgetting_attention(q, k, v, log_f):
    b, s, h, hd = q.shape
    nb = s // Q_BLOCK
    scale = 1.0 / math.sqrt(hd)
    cum = jnp.cumsum(log_f.astype(jnp.float32), axis=1).transpose(0, 2, 1)
    q = q.transpose(0, 2, 1, 3)
    k = k.transpose(0, 2, 1, 3)
    v = v.transpose(0, 2, 1, 3)
    qb = q.reshape(b, h, nb, Q_BLOCK, hd).transpose(2, 0, 1, 3, 4)
    cb = cum.reshape(b, h, nb, Q_BLOCK).transpose(2, 0, 1, 3)
    kpos = jnp.arange(s)

    def one_block(args):
        qi, ci, blk = args
        qpos = blk * Q_BLOCK + jnp.arange(Q_BLOCK)
        logits = jnp.einsum("bhqd,bhkd->bhqk", qi, k).astype(jnp.float32) * scale
        logits = logits + ci[..., :, None] - cum[:, :, None, :]
        logits = jnp.where(kpos[None, :] <= qpos[:, None], logits, -jnp.inf)
        p = jax.nn.softmax(logits, axis=-1)
        return jnp.einsum("bhqk,bhkd->bhqd", p.astype(v.dtype), v)

    o = lax.map(one_block, (qb, cb, jnp.arange(nb)))
    return o.transpose(1, 0, 3, 2, 4).reshape(b, s, h * hd)


def conformer_conv(u, w_dw, b_dw, ln_g, ln_b):
    a, gate = u[..., :D_CONV], u[..., D_CONV:]
    y = a * jax.nn.sigmoid(gate)
    y = causal_dwconv(y, w_dw, b_dw)
    y = layer_norm(y, ln_g, ln_b)
    return jax.nn.silu(y)


def _lin_combine(c1, c2):
    a1, b1 = c1
    a2, b2 = c2
    return a1 * a2, a2 * b1 + b2


def rglru_block(xr, gate_in, conv_w, conv_b, w_r, b_r, w_i, b_i, lam):
    xr = causal_dwconv(xr, conv_w, conv_b)
    b, s, c = xr.shape
    xh = xr.reshape(b, s, RNN_BLOCKS, RNN_BD)
    r = jax.nn.sigmoid(jnp.einsum("bshi,hij->bshj", xh, w_r).reshape(b, s, c) + b_r)
    i = jax.nn.sigmoid(jnp.einsum("bshi,hij->bshj", xh, w_i).reshape(b, s, c) + b_i)
    log_a = -RG_C * r.astype(jnp.float32) * jax.nn.softplus(-lam.astype(jnp.float32))
    a = jnp.exp(log_a)
    mult = jnp.sqrt(-jnp.expm1(2.0 * log_a))
    bterm = mult * (i * xr).astype(jnp.float32)
    _, hs = lax.associative_scan(_lin_combine, (a, bterm), axis=1)
    return hs.astype(xr.dtype) * jax.nn.gelu(gate_in)


def peer(xn, wq, k1, k2, u_tab, v_tab):
    b, s, d = xn.shape
    t = b * s
    xt = xn.reshape(t, d)
    q = (xt @ wq).reshape(t, PEER_HEADS, D_KEY)
    q1, q2 = q[..., :D_HALF], q[..., D_HALF:]
    s1 = jnp.einsum("thd,hnd->thn", q1, k1).astype(jnp.float32)
    s2 = jnp.einsum("thd,hnd->thn", q2, k2).astype(jnp.float32)
    v1, i1 = lax.top_k(s1, TOPK)
    v2, i2 = lax.top_k(s2, TOPK)
    cand = (v1[..., :, None] + v2[..., None, :]).reshape(t, PEER_HEADS, TOPK * TOPK)
    sv, ci = lax.top_k(cand, TOPK)
    e1 = jnp.take_along_axis(i1, ci // TOPK, axis=-1)
    e2 = jnp.take_along_axis(i2, ci % TOPK, axis=-1)
    nc = t // TOK_CHUNK
    experts = (e1 * N_KEYS + e2).reshape(nc, TOK_CHUNK, PEER_HEADS * TOPK)
    gates = jax.nn.softmax(sv, axis=-1).astype(xn.dtype).reshape(nc, TOK_CHUNK, PEER_HEADS * TOPK)
    xc = xt.reshape(nc, TOK_CHUNK, d)

    def chunk(args):
        xi, ei, gi = args
        hid = jax.nn.gelu(jnp.einsum("td,tkd->tk", xi, u_tab[ei]))
        return jnp.einsum("tk,tkd->td", gi * hid, v_tab[ei])

    out = lax.map(chunk, (xc, experts, gates))
    return out.reshape(b, s, d)


def setup_inputs(seed: int = 0) -> dict:
    key = jax.random.key(seed)
    ks = jax.random.split(key, 26)
    L, D = DEPTH, D_MODEL
    nrm = jax.random.normal
    u_lr = jax.random.uniform(ks[14], (L, D_RNN), minval=0.9, maxval=0.999)
    p_lr = u_lr ** (1.0 / RG_C)
    lam = jnp.log(p_lr) - jnp.log1p(-p_lr)
    return {
        "x": nrm(ks[0], (BATCH, SEQ, D), jnp.float32),
        "norm1_g": 1.0 + 0.01 * nrm(ks[1], (L, D)),
        "w_in": nrm(ks[2], (L, D, N_IN)) * D ** -0.5,
        "b_forget": jax.random.uniform(ks[3], (L, ATT_HEADS), minval=1.0, maxval=5.0),
        "conv_dw_w": nrm(ks[4], (L, CONV_K, D_CONV)) * CONV_K ** -0.5,
        "conv_dw_b": 0.01 * nrm(ks[5], (L, D_CONV)),
        "conv_ln_g": 1.0 + 0.01 * nrm(ks[6], (L, D_CONV)),
        "conv_ln_b": 0.01 * nrm(ks[7], (L, D_CONV)),
        "rg_conv_w": nrm(ks[8], (L, RNN_CONV_K, D_RNN)) * RNN_CONV_K ** -0.5,
        "rg_conv_b": 0.01 * nrm(ks[9], (L, D_RNN)),
        "rg_w_r": nrm(ks[10], (L, RNN_BLOCKS, RNN_BD, RNN_BD)) * RNN_BD ** -0.5,
        "rg_b_r": 0.01 * nrm(ks[11], (L, D_RNN)),
        "rg_w_i": nrm(ks[12], (L, RNN_BLOCKS, RNN_BD, RNN_BD)) * RNN_BD ** -0.5,
        "rg_b_i": 0.01 * nrm(ks[13], (L, D_RNN)),
        "rg_lambda": lam,
        "w_out": nrm(ks[15], (L, D_MIX, D)) * D_MIX ** -0.5,
        "norm2_g": 1.0 + 0.01 * nrm(ks[16], (L, D)),
        "peer_wq": nrm(ks[17], (L, D, PEER_HEADS * D_KEY)) * D ** -0.5,
        "peer_k1": nrm(ks[18], (L, PEER_HEADS, N_KEYS, D_HALF)) * D_HALF ** -0.5,
        "peer_k2": nrm(ks[19], (L, PEER_HEADS, N_KEYS, D_HALF)) * D_HALF ** -0.5,
        "peer_u": nrm(ks[20], (L, N_EXPERTS, D)) * D ** -0.5,
        "peer_v": nrm(ks[21], (L, N_EXPERTS, D)) * 0.5 * PEER_HEADS ** -0.5,
        "final_g": 1.0 + 0.01 * nrm(ks[22], (D,)),
    }


def reference(x, norm1_g, w_in, b_forget, conv_dw_w, conv_dw_b, conv_ln_g, conv_ln_b,
              rg_conv_w, rg_conv_b, rg_w_r, rg_b_r, rg_w_i, rg_b_i, rg_lambda, w_out,
              norm2_g, peer_wq, peer_k1, peer_k2, peer_u, peer_v, final_g):
    b, s, _ = x.shape
    for l in range(DEPTH):
        h = rms_norm(x, norm1_g[l])
        proj = h @ w_in[l]
        q = proj[..., Q0:Q1].reshape(b, s, ATT_HEADS, ATT_HD)
        k = proj[..., K0:K1].reshape(b, s, ATT_HEADS, ATT_HD)
        v = proj[..., V0:V1].reshape(b, s, ATT_HEADS, ATT_HD)
        log_f = jax.nn.log_sigmoid((proj[..., F0:F1] + b_forget[l]).astype(jnp.float32))
        y_att = forgetting_attention(q, k, v, log_f)
        y_conv = conformer_conv(proj[..., C0:C1], conv_dw_w[l], conv_dw_b[l],
                                conv_ln_g[l], conv_ln_b[l])
        y_rnn = rglru_block(proj[..., R0:R1], proj[..., G0:G1], rg_conv_w[l], rg_conv_b[l],
                            rg_w_r[l], rg_b_r[l], rg_w_i[l], rg_b_i[l], rg_lambda[l])
        mixed = jnp.concatenate([y_att, y_conv.astype(x.dtype), y_rnn.astype(x.dtype)], axis=-1)
        x = x + mixed @ w_out[l]
        h2 = rms_norm(x, norm2_g[l])
        x = x + peer(h2, peer_wq[l], peer_k1[l], peer_k2[l], peer_u[l], peer_v[l])
    return rms_norm(x, final_g)
```

```cpp
#include <hip/hip_runtime.h>
#include <hip/hip_cooperative_groups.h>
#include <cstdint>
#include <cstdio>
namespace cg = cooperative_groups;

typedef unsigned short bf16_t;
typedef short bf16x8 __attribute__((ext_vector_type(8)));
typedef float f32x4 __attribute__((ext_vector_type(4)));
typedef float f32x16 __attribute__((ext_vector_type(16)));
typedef float f32x2 __attribute__((ext_vector_type(2)));
typedef __bf16 v2bf __attribute__((ext_vector_type(2)));
typedef unsigned u32x4 __attribute__((ext_vector_type(4)));
typedef int i32x4 __attribute__((ext_vector_type(4)));

constexpr int T = 32768, D = 1024, S = 8192;
constexpr int NIN = 2568, NINP = 2688;
constexpr int F0 = 1536, C0 = 1544, R0 = 2056, G0 = 2312;
constexpr float EPS = 1e-6f;
constexpr float LOG2E = 1.4426950408889634f;
constexpr int NTHREADS = 256;
constexpr int SMEM_BYTES = 52224;

struct Params {
    const float *x, *norm1_g, *w_in, *b_forget, *conv_w, *conv_b, *ln_g, *ln_b;
    const float *rg_conv_w, *rg_conv_b, *rg_w_r, *rg_b_r, *rg_w_i, *rg_b_i, *rg_lambda;
    const float *w_out, *norm2_g, *wq, *k1, *k2, *pu, *pv, *final_g;
    float* out;
    bf16_t *WinT, *WoutT, *WcT, *proj, *mixed, *hloc, *Pc;
    unsigned* HP; float* AB;
    unsigned char *U8, *V8;
    float *su, *sv;
    float *logf, *kb, *Aagg, *Bagg, *scT, *gates, *rstd2, *part, *wbuf;
    bf16_t* xb;
    float *ssqA, *ssqE;
    int* experts;
    unsigned* ctr; unsigned* bar;
};

__device__ __forceinline__ unsigned pk_bf16(float lo, float hi) { unsigned r; asm("v_cvt_pk_bf16_f32 %0, %1, %2" : "=v"(r) : "v"(lo), "v"(hi)); return r; }
__device__ __forceinline__ bf16_t f2bf(float f) { return (bf16_t)(pk_bf16(f, 0.f) & 0xffffu); }
__device__ __forceinline__ float bf2f(bf16_t b) { return __uint_as_float(((unsigned)b) << 16); }
__device__ __forceinline__ float bflo(unsigned u) { return __uint_as_float(u << 16); }
__device__ __forceinline__ float bfhi(unsigned u) { return __uint_as_float(u & 0xffff0000u); }
__device__ __forceinline__ float sigmoidf_(float x) { return 1.0f / (1.0f + __expf(-x)); }
__device__ __forceinline__ float gelu_tanh(float x) { const float u = 0.7978845608028654f * (x + 0.044715f * x * x * x); return x / (1.0f + __expf(-2.0f * u)); }
__device__ __forceinline__ int get_tid() { int t = threadIdx.x; asm volatile("" : "+v"(t)); return t; }
__device__ __forceinline__ int get_bid() { int b = blockIdx.x; asm volatile("" : "+s"(b)); return b; }
__device__ __forceinline__ float log1p_pos(float x) { return x < 0.0625f ? x * (1.0f - x * (0.5f - x * (0.33333334f - x * (0.25f - x * 0.2f)))) : __logf(1.0f + x); }
__device__ __forceinline__ float neg_expm1_neg(float y) { return y > -0.25f ? -y * (1.0f + 0.5f * y * (1.0f + 0.33333334f * y * (1.0f + 0.25f * y * (1.0f + 0.2f * y * (1.0f + 0.16666667f * y))))) : 1.0f - __expf(y); }
__device__ __forceinline__ float wave_sum(float v) {
#pragma unroll
    for (int o = 32; o >= 1; o >>= 1) v += __shfl_xor(v, o);
    return v;
}

__device__ void prep_transpose(const float* src, int ldn, int nvalid, const float* g, bf16_t* dst, int kt, int nt, char* smem) {
    float* sm = (float*)smem;
    const int tid = get_tid(), col = tid & 63, r0 = tid >> 6;
#pragma unroll 4
    for (int i = 0; i < 16; ++i) {
        const int row = r0 + 4 * i, k = kt * 64 + row, n = nt * 64 + col;
        float v = 0.f;
        if (n < nvalid) { v = src[(size_t)k * ldn + n]; if (g) v *= g[k]; }
        sm[row * 65 + col] = v;
    }
    __syncthreads();
#pragma unroll 4
    for (int i = 0; i < 16; ++i) {
        const int nl = r0 + 4 * i;
        dst[(size_t)(nt * 64 + nl) * 1024 + kt * 64 + col] = f2bf(sm[col * 65 + nl]);
    }
    __syncthreads();
}

__device__ void prep_wc(const Params& p, int l, int item, char* smem) {
    float* sK = (float*)smem;
    float* sW = sK + 64 * 65;
    const int dt = item & 15, jt = (item >> 4) & 1, hp = item >> 5, h = hp >> 1, pp = hp & 1;
    const float* Kp = (pp ? p.k2 : p.k1) + ((size_t)(l * 8 + h) * 128) * 128;
    const float* Wq = p.wq + (size_t)l * 1024 * 2048 + h * 256 + pp * 128;
    const int tid = get_tid(), cl = tid & 63, r0 = tid >> 6, tx = tid & 15, ty = tid >> 4;
    float acc[4][4];
#pragma unroll
    for (int a = 0; a < 4; ++a)
#pragma unroll
        for (int b = 0; b < 4; ++b) acc[a][b] = 0.f;
    for (int ch = 0; ch < 2; ++ch) {
#pragma unroll 4
        for (int i = 0; i < 16; ++i) {
            const int rl = r0 + 4 * i;
            sK[rl * 65 + cl] = Kp[(size_t)(jt * 64 + rl) * 128 + ch * 64 + cl];
            sW[rl * 65 + cl] = Wq[(size_t)(dt * 64 + rl) * 2048 + ch * 64 + cl];
        }
        __syncthreads();
#pragma unroll 8
        for (int c = 0; c < 64; ++c) {
            float kv[4], wv[4];
#pragma unroll
            for (int a = 0; a < 4; ++a) { kv[a] = sK[(ty * 4 + a) * 65 + c]; wv[a] = sW[(tx * 4 + a) * 65 + c]; }
#pragma unroll
            for (int a = 0; a < 4; ++a)
#pragma unroll
                for (int b = 0; b < 4; ++b) acc[a][b] += kv[a] * wv[b];
        }
        __syncthreads();
    }
    const float* g2 = p.norm2_g + l * 1024 + dt * 64 + tx * 4;
    const float g0 = g2[0], g1 = g2[1], g2v = g2[2], g3 = g2[3];
#pragma unroll
    for (int a = 0; a < 4; ++a) {
        const int n = hp * 128 + jt * 64 + ty * 4 + a;
        uint2 w; w.x = pk_bf16(acc[a][0] * g0, acc[a][1] * g1); w.y = pk_bf16(acc[a][2] * g2v, acc[a][3] * g3);
        *(uint2*)(p.WcT + ((size_t)l * 2048 + n) * 1024 + dt * 64 + tx * 4) = w;
    }
}

__device__ void prep_fp8_row(const float* src, unsigned char* dst8, float* scale, int row  , int lane) {
    const float* r = src + (size_t)row * 1024 + lane * 16;
    f32x4 v[4];
#pragma unroll
    for (int i = 0; i < 4; ++i) v[i] = __builtin_nontemporal_load((const f32x4*)(r + 4 * i));
    float am = 0.f;
#pragma unroll
    for (int i = 0; i < 4; ++i) am = fmaxf(am, fmaxf(fmaxf(fabsf(v[i][0]), fabsf(v[i][1])), fmaxf(fabsf(v[i][2]), fabsf(v[i][3]))));
#pragma unroll
    for (int o = 32; o >= 1; o >>= 1) am = fmaxf(am, __shfl_xor(am, o));
    const float sc = am > 0.f ? am * (1.0f / 127.0f) : 1.0f, inv = am > 0.f ? 127.0f / am : 0.0f;
    u32x4 w;
#pragma unroll
    for (int i = 0; i < 4; ++i) {
        const int q0 = __float2int_rn(v[i][0] * inv), q1 = __float2int_rn(v[i][1] * inv), q2 = __float2int_rn(v[i][2] * inv), q3 = __float2int_rn(v[i][3] * inv);
        w[i] = (unsigned)(q0 & 255) | ((unsigned)(q1 & 255) << 8) | ((unsigned)(q2 & 255) << 16) | ((unsigned)q3 << 24);
    }
    const int l = row >> 14, e = row & 16383, x = lane >> 3, c = lane & 7;
    *(u32x4*)(dst8 + ((size_t)(l * 8 + x) * 16384 + e) * 128 + c * 16) = w;
    if (lane == 0) scale[row] = sc;
}

__device__ void prep_x_row(const Params& p, int t, int lane) {
    const float* xr = p.x + (size_t)t * 1024;
    float ss = 0.f;
#pragma unroll
    for (int i = 0; i < 2; ++i) {
        const f32x4 a = *(const f32x4*)(xr + i * 512 + lane * 8), b = *(const f32x4*)(xr + i * 512 + lane * 8 + 4);
        ss += a[0] * a[0] + a[1] * a[1] + a[2] * a[2] + a[3] * a[3] + b[0] * b[0] + b[1] * b[1] + b[2] * b[2] + b[3] * b[3];
        u32x4 w; w.x = pk_bf16(a[0], a[1]); w.y = pk_bf16(a[2], a[3]); w.z = pk_bf16(b[0], b[1]); w.w = pk_bf16(b[2], b[3]);
        *(u32x4*)(p.xb + (size_t)t * 1024 + i * 512 + lane * 8) = w;
    }
    ss = wave_sum(ss);
    if (lane == 0) p.ssqA[t] = ss;
}

__device__ void phase_prep(const Params& p, char* smem) {
    { const int tid = get_tid(); for (int t = get_bid() * 4 + (tid >> 6); t < T; t += gridDim.x * 4) prep_x_row(p, t, tid & 63); }
    for (int it = get_bid(); it < 2880; it += gridDim.x) {
        if (it < 1344) { const int l = it / 672, r = it % 672, kt = r / 42, nt = r % 42;
            prep_transpose(p.w_in + (size_t)l * 1024 * NIN, NIN, NIN, p.norm1_g + l * 1024, p.WinT + (size_t)l * NINP * 1024, kt, nt, smem);
        } else if (it < 1856) { const int j = it - 1344, l = j / 256, r = j % 256, kt = r / 16, nt = r % 16;
            prep_transpose(p.w_out + (size_t)l * 1024 * 1024, 1024, 1024, nullptr, p.WoutT + (size_t)l * 1024 * 1024, kt, nt, smem);
        } else if (it < 2880) { const int j = it - 1856; prep_wc(p, j / 512, j % 512, smem);
        }
    }
}

template <int AF32, int SWAP, class Epi>
__device__ __forceinline__ void gemm_tile(const void* Aptr, const bf16_t* Bt, int tm, int tn, const Epi& epi, char* smem, const float* ssq = nullptr, int nparts = 0) {
    constexpr int K = 1024;
    bf16_t* sA = (bf16_t*)smem;
    bf16_t* sB = sA + 2 * 4096;
    float* sRs = (float*)(smem + 32768);
    const int tid = get_tid(), lane = tid & 63, wid = tid >> 6, wr = wid >> 1, wc = wid & 1, fr = lane & 15, fq = lane >> 4;
    f32x4 acc[4][4];
#pragma unroll
    for (int m = 0; m < 4; ++m)
#pragma unroll
        for (int n = 0; n < 4; ++n) acc[m][n] = (f32x4){0.f, 0.f, 0.f, 0.f};
    float ss[4] = {0.f, 0.f, 0.f, 0.f};
    struct Stage { f32x4 ra[4]; u32x4 rab[2]; u32x4 rb[2]; };
    Stage st0, st1;
    const float* Af = (const float*)Aptr + (size_t)tm * 128 * K;
    const bf16_t* Ab = (const bf16_t*)Aptr + (size_t)tm * 128 * K;
    const bf16_t* Bp = Bt + (size_t)tn * 128 * K;
    auto gload = [&](int kt, Stage& st) {
        if (AF32) {
#pragma unroll
            for (int i = 0; i < 4; ++i) st.ra[i] = *(const f32x4*)(Af + (size_t)((tid >> 3) + 32 * i) * K + kt * 32 + (tid & 7) * 4);
        } else {
#pragma unroll
            for (int i = 0; i < 2; ++i) { const int c = tid + 256 * i; st.rab[i] = *(const u32x4*)(Ab + (size_t)(c >> 2) * K + kt * 32 + (c & 3) * 8); }
        }
#pragma unroll
        for (int i = 0; i < 2; ++i) { const int c = tid + 256 * i; st.rb[i] = *(const u32x4*)(Bp + (size_t)(c >> 2) * K + kt * 32 + (c & 3) * 8); }
    };
    auto sstore = [&](int buf, const Stage& st) {
        if (AF32) {
#pragma unroll
            for (int i = 0; i < 4; ++i) {
                const f32x4 v = st.ra[i];
                ss[i] += v.x * v.x + v.y * v.y + v.z * v.z + v.w * v.w;
                uint2 w; w.x = pk_bf16(v.x, v.y); w.y = pk_bf16(v.z, v.w);
                { const int r = (tid >> 3) + 32 * i, hc = tid & 7; *(uint2*)(sA + buf * 4096 + r * 32 + (((hc >> 1) ^ ((r >> 2) & 3)) * 8) + (hc & 1) * 4) = w; }
            }
        } else {
#pragma unroll
            for (int i = 0; i < 2; ++i) { const int c = tid + 256 * i, r = c >> 2; *(u32x4*)(sA + buf * 4096 + r * 32 + ((c & 3) ^ ((r >> 2) & 3)) * 8) = st.rab[i]; }
        }
#pragma unroll
        for (int i = 0; i < 2; ++i) { const int c = tid + 256 * i, r = c >> 2; *(u32x4*)(sB + buf * 4096 + r * 32 + ((c & 3) ^ ((r >> 2) & 3)) * 8) = st.rb[i]; }
    };
    auto compute = [&](int buf) {
        bf16x8 af[4], bfr[4];
#pragma unroll
        for (int m = 0; m < 4; ++m) { const int r = wr * 64 + m * 16 + fr; af[m] = *(const bf16x8*)(sA + buf * 4096 + r * 32 + (fq ^ ((r >> 2) & 3)) * 8); }
#pragma unroll
        for (int n = 0; n < 4; ++n) { const int r = wc * 64 + (SWAP ? ((fr >> 2) * 16 + n * 4 + (fr & 3)) : (n * 16 + fr)); bfr[n] = *(const bf16x8*)(sB + buf * 4096 + r * 32 + (fq ^ ((r >> 2) & 3)) * 8); }
#pragma unroll
        for (int m = 0; m < 4; ++m)
#pragma unroll
            for (int n = 0; n < 4; ++n)
                acc[m][n] = SWAP ? __builtin_amdgcn_mfma_f32_16x16x32_bf16(bfr[n], af[m], acc[m][n], 0, 0, 0)
                                 : __builtin_amdgcn_mfma_f32_16x16x32_bf16(af[m], bfr[n], acc[m][n], 0, 0, 0);
    };
    if (nparts > 0 && tid < 128) {
        float sq = 0.f;
        for (int q = 0; q < nparts; ++q) sq += ssq[(size_t)q * T + (size_t)tm * 128 + tid];
        sRs[tid] = rsqrtf(sq * (1.0f / 1024.0f) + EPS);
    }
    gload(0, st0); sstore(0, st0); gload(1, st1); __syncthreads();
    for (int kt = 0; kt < 32; kt += 2) {
        gload(min(kt + 2, 31), st0);
        compute(0);
        sstore(1, st1);
        __syncthreads();
        gload(min(kt + 3, 31), st1);
        compute(1);
        if (kt + 2 < 32) sstore(0, st0);
        __syncthreads();
    }
    if (AF32) {
#pragma unroll
        for (int i = 0; i < 4; ++i) {
            float s = ss[i];
            s += __shfl_xor(s, 1); s += __shfl_xor(s, 2); s += __shfl_xor(s, 4);
            if ((tid & 7) == 0) sRs[(tid >> 3) + 32 * i] = rsqrtf(s * (1.0f / 1024.0f) + EPS);
        }
        __syncthreads();
    }
    epi(acc, tm, tn, wr, wc, fr, fq, sRs);
}

__device__ __forceinline__ bool gemm_ticket(unsigned* ctr, int nt, int& tm, int& tn, char* smem) {
    int* sT = (int*)(smem + 32768 + 512);
    const int xcd = get_bid() & 7;
    if (get_tid() == 0) sT[0] = (int)atomicAdd(ctr + xcd * 32, 1u);
    __syncthreads();
    const int j = sT[0];
    if (j >= 32 * nt) return false;
    const int full = nt >> 3, rem = nt & 7;
    int tn_g, tm_g, q;
    if (j < full * 256) { tn_g = j >> 8; const int r = j & 255; tm_g = r >> 6; q = r & 63; }
    else { const int r = j - full * 256; tn_g = full; tm_g = r / (8 * rem); q = r % (8 * rem); }
    tm = ((tm_g * 8 + (q & 7)) * 8) + xcd; tn = tn_g * 8 + (q >> 3); return true;
}


template <class Epi>
__device__ __forceinline__ void gemm_tile64(const bf16_t* A, const bf16_t* Bt, int tm, int tn, const Epi& epi, char* smem, const float* ssq, int nparts) {
    constexpr int K = 1024;
    bf16_t* sA = (bf16_t*)smem;
    bf16_t* sB = sA + 8192;
    float* sRs = (float*)(smem + 32768);
    const int tid = get_tid(), lane = tid & 63, wid = tid >> 6, wr = wid >> 1, wc = wid & 1, fr = lane & 15, fq = lane >> 4;
    f32x4 acc[4][4];
#pragma unroll
    for (int m = 0; m < 4; ++m)
#pragma unroll
        for (int n = 0; n < 4; ++n) acc[m][n] = (f32x4){0.f, 0.f, 0.f, 0.f};
    if (nparts > 0 && tid < 128) {
        float sq = 0.f;
        for (int q = 0; q < nparts; ++q) sq += ssq[(size_t)q * T + (size_t)tm * 128 + tid];
        sRs[tid] = rsqrtf(sq * (1.0f / 1024.0f) + EPS);
    }
    const int lrow = tid >> 3, lc8 = tid & 7;
    const bf16_t* Ap = A + ((size_t)tm * 128 + lrow) * K + lc8 * 8;
    const bf16_t* Bp = Bt + ((size_t)tn * 128 + lrow) * K + lc8 * 8;
    struct Slab { u32x4 a[4], b[4]; };
    auto gload = [&](int kt, Slab& sl) {
#pragma unroll
        for (int i = 0; i < 4; ++i) { sl.a[i] = *(const u32x4*)(Ap + (size_t)(32 * i) * K + kt * 64); sl.b[i] = *(const u32x4*)(Bp + (size_t)(32 * i) * K + kt * 64); }
    };
    auto sstore = [&](const Slab& sl) {
#pragma unroll
        for (int i = 0; i < 4; ++i) {
            const int r = lrow + 32 * i;
            *(u32x4*)(sA + r * 64 + ((lc8 ^ ((r >> 1) & 7)) * 8)) = sl.a[i];
            const int rs = (r & 64) | (((r >> 2) & 3) << 4) | (((r >> 4) & 3) << 2) | (r & 3);
            *(u32x4*)(sB + rs * 64 + ((lc8 ^ ((rs >> 1) & 7)) * 8)) = sl.b[i];
        }
    };
    auto compute = [&]() {
#pragma unroll
        for (int ks = 0; ks < 2; ++ks) {
            bf16x8 af[4], bfr[4];
#pragma unroll
            for (int m = 0; m < 4; ++m) { const int r = wr * 64 + m * 16 + fr; af[m] = *(const bf16x8*)(sA + r * 64 + (((ks * 4 + fq) ^ ((r >> 1) & 7)) * 8)); }
#pragma unroll
            for (int n = 0; n < 4; ++n) { const int r = wc * 64 + n * 16 + fr; bfr[n] = *(const bf16x8*)(sB + r * 64 + (((ks * 4 + fq) ^ ((r >> 1) & 7)) * 8)); }
#pragma unroll
            for (int m = 0; m < 4; ++m)
#pragma unroll
                for (int n = 0; n < 4; ++n) acc[m][n] = __builtin_amdgcn_mfma_f32_16x16x32_bf16(bfr[n], af[m], acc[m][n], 0, 0, 0);
        }
    };
    Slab s0;
    gload(0, s0);
    for (int kt = 0; kt < 16; ++kt) {
        __syncthreads(); sstore(s0); __syncthreads();
        gload(min(kt + 1, 15), s0);
        compute();
    }
    epi(acc, tm, tn, wr, wc, fr, fq, sRs);
}

__device__ __forceinline__ bool gemm_next(int it, int nt, int& tm, int& tn) {
    const int G8 = gridDim.x >> 3;
    const int xcd = get_bid() & 7, slot = get_bid() >> 3;
    const int j = it * G8 + slot;
    if (j >= 32 * nt) return false;
    const int full = nt >> 3, rem = nt & 7;
    int tn_g, tm_g, q;
    if (j < full * 256) { tn_g = j >> 8; const int r = j & 255; tm_g = r >> 6; q = r & 63; }
    else { const int r = j - full * 256; tn_g = full; tm_g = r / (8 * rem); q = r % (8 * rem); }
    tm = ((tm_g * 8 + (q & 7)) * 8) + xcd; tn = tn_g * 8 + (q >> 3); return true;
}

struct EpiInProj {
    const Params* p; int l;
    __device__ __forceinline__ void operator()(const f32x4 (&acc)[4][4], int tm, int tn, int wr, int wc, int fr, int fq, const float* sRs) const {
        const int col0 = tn * 128 + wc * 64 + fq * 16;
#pragma unroll
        for (int m = 0; m < 4; ++m) {
            const int rl = wr * 64 + m * 16 + fr; const float rs = sRs[rl]; const size_t row = (size_t)tm * 128 + rl;
            const f32x4 v0 = acc[m][0] * rs, v1 = acc[m][1] * rs, v2 = acc[m][2] * rs, v3 = acc[m][3] * rs;
            if (col0 == F0) {
                const float* bf = p->b_forget + l * 8;
                f32x4 o0, o1;
#pragma unroll
                for (int j = 0; j < 4; ++j) {
                    const float z0 = v0[j] + bf[j], z1 = v1[j] + bf[4 + j];
                    o0[j] = fminf(z0, 0.f) - log1p_pos(__expf(-fabsf(z0))); o1[j] = fminf(z1, 0.f) - log1p_pos(__expf(-fabsf(z1)));
                }
                *(f32x4*)(p->logf + row * 8) = o0; *(f32x4*)(p->logf + row * 8 + 4) = o1;
            }
            if (col0 + 8 <= NIN) { u32x4 w; w.x = pk_bf16(v0[0], v0[1]); w.y = pk_bf16(v0[2], v0[3]); w.z = pk_bf16(v1[0], v1[1]); w.w = pk_bf16(v1[2], v1[3]); *(u32x4*)(p->proj + row * NIN + col0) = w; }
            if (col0 + 16 <= NIN) { u32x4 w; w.x = pk_bf16(v2[0], v2[1]); w.y = pk_bf16(v2[2], v2[3]); w.z = pk_bf16(v3[0], v3[1]); w.w = pk_bf16(v3[2], v3[3]); *(u32x4*)(p->proj + row * NIN + col0 + 8) = w; }
        }
    }
};

struct EpiOutProj {
    const float* xin; float* xout; bf16_t* xb; float* ssq;
    __device__ __forceinline__ void operator()(const f32x4 (&acc)[4][4], int tm, int tn, int wr, int wc, int fr, int fq, const float*) const {
        const int col0 = tn * 128 + wc * 64 + fq * 16;
#pragma unroll
        for (int m = 0; m < 4; ++m) {
            const size_t row = (size_t)tm * 128 + wr * 64 + m * 16 + fr;
            f32x4 o[4]; float sq = 0.f;
#pragma unroll
            for (int n = 0; n < 4; ++n) {
                o[n] = *(const f32x4*)(xin + row * 1024 + col0 + n * 4) + acc[m][n];
                *(f32x4*)(xout + row * 1024 + col0 + n * 4) = o[n];
                sq += o[n][0] * o[n][0] + o[n][1] * o[n][1] + o[n][2] * o[n][2] + o[n][3] * o[n][3];
            }
            u32x4 w0, w1;
            w0.x = pk_bf16(o[0][0], o[0][1]); w0.y = pk_bf16(o[0][2], o[0][3]); w0.z = pk_bf16(o[1][0], o[1][1]); w0.w = pk_bf16(o[1][2], o[1][3]);
            w1.x = pk_bf16(o[2][0], o[2][1]); w1.y = pk_bf16(o[2][2], o[2][3]); w1.z = pk_bf16(o[3][0], o[3][1]); w1.w = pk_bf16(o[3][2], o[3][3]);
            *(u32x4*)(xb + row * 1024 + col0) = w0; *(u32x4*)(xb + row * 1024 + col0 + 8) = w1;
            sq += __shfl_xor(sq, 16); sq += __shfl_xor(sq, 32);
            if (fq == 0) ssq[(size_t)(tn * 2 + wc) * T + row] = sq;
        }
    }
};

struct EpiScores {
    float* scT; float* rstd2;
    __device__ __forceinline__ void operator()(const f32x4 (&acc)[4][4], int tm, int tn, int wr, int wc, int fr, int fq, const float* sRs) const {
#pragma unroll
        for (int m = 0; m < 4; ++m) {
            const int rl = wr * 64 + m * 16 + fr;
            const float rs = sRs[rl];
            if (tn == 0 && wc == 0 && fq == 0) rstd2[(size_t)tm * 128 + rl] = rs;
#pragma unroll
            for (int n = 0; n < 4; ++n) {
                const int col = tn * 128 + wc * 64 + fq * 16 + n * 4;
                __builtin_nontemporal_store(acc[m][n] * rs, (f32x4*)(scT + (((size_t)(tm * 2 + (rl >> 6)) * 512 + (col >> 2)) * 64 + (rl & 63)) * 4));
            }
        }
    }
};

__device__ void cumsum_item(const Params& p, int bh, char* smem) {
    float* sm = (float*)smem;
    const int b = bh >> 3, h = bh & 7, tid = get_tid(), lane = tid & 63, wid = tid >> 6;
    const float* src = p.logf + ((size_t)b * S + tid * 32) * 8 + h;
    float loc[32]; float run = 0.f;
#pragma unroll
    for (int i = 0; i < 32; ++i) { run += src[i * 8]; loc[i] = run; }
    float incl = run;
#pragma unroll
    for (int o = 1; o < 64; o <<= 1) { const float t = __shfl_up(incl, o); if (lane >= o) incl += t; }
    if (lane == 63) sm[wid] = incl;
    __syncthreads();
    float wbase = 0.f;
    for (int w = 0; w < wid; ++w) wbase += sm[w];
    const float excl = wbase + incl - run;
    float* dst = p.kb + (size_t)bh * S + tid * 32;
#pragma unroll
    for (int i = 0; i < 32; i += 4) {
        float4 o; o.x = -(excl + loc[i]) * LOG2E; o.y = -(excl + loc[i + 1]) * LOG2E; o.z = -(excl + loc[i + 2]) * LOG2E; o.w = -(excl + loc[i + 3]) * LOG2E;
        *(float4*)(dst + i) = o;
    }
    __syncthreads();
}

__device__ void conv_item(const Params& p, int l, int item, char* smem) {
    bf16_t* sG = (bf16_t*)smem;
    float* sY = (float*)(smem + 46 * 256 * 2);
    const int b = item >> 9, tt = item & 511, t0 = tt * 16, tid = get_tid(), lane = tid & 63, wid = tid >> 6;
    const bf16_t* projb = p.proj + (size_t)b * S * NIN;
#pragma unroll
    for (int i = 0; i < 6; ++i) {
        const int task = tid + 256 * i, r = task >> 5, cc = task & 31;
        if (r < 46) {
            const int t = t0 - 30 + r;
            uint4 w = {0u, 0u, 0u, 0u};
            if (t >= 0) {
                const uint4 a = *(const uint4*)(projb + (size_t)t * NIN + C0 + cc * 8);
                const uint4 g = *(const uint4*)(projb + (size_t)t * NIN + C0 + 256 + cc * 8);
                w.x = pk_bf16(bflo(a.x) * sigmoidf_(bflo(g.x)), bfhi(a.x) * sigmoidf_(bfhi(g.x)));
                w.y = pk_bf16(bflo(a.y) * sigmoidf_(bflo(g.y)), bfhi(a.y) * sigmoidf_(bfhi(g.y)));
                w.z = pk_bf16(bflo(a.z) * sigmoidf_(bflo(g.z)), bfhi(a.z) * sigmoidf_(bfhi(g.z)));
                w.w = pk_bf16(bflo(a.w) * sigmoidf_(bflo(g.w)), bfhi(a.w) * sigmoidf_(bfhi(g.w)));
            }
            *(uint4*)(sG + r * 256 + cc * 8) = w;
        }
    }
    float wk[31];
#pragma unroll
    for (int k = 0; k < 31; ++k) wk[k] = p.conv_w[((size_t)l * 31 + k) * 256 + tid];
    const float bias = p.conv_b[l * 256 + tid];
    __syncthreads();
#pragma unroll 1
    for (int tl = 0; tl < 16; ++tl) {
        float y = bias;
#pragma unroll
        for (int k = 0; k < 31; ++k) y += wk[k] * bf2f(sG[(tl + k) * 256 + tid]);
        sY[tl * 256 + tid] = y;
    }
    __syncthreads();
    const float4 g4 = *(const float4*)(p.ln_g + l * 256 + lane * 4), b4 = *(const float4*)(p.ln_b + l * 256 + lane * 4);
#pragma unroll
    for (int j = 0; j < 4; ++j) {
        const int tl = wid * 4 + j;
        const float4 y = *(const float4*)(sY + tl * 256 + lane * 4);
        const float s1 = wave_sum(y.x + y.y + y.z + y.w);
        const float mean = s1 * (1.0f / 256.0f);
        const float dx = y.x - mean, dy = y.y - mean, dz = y.z - mean, dw = y.w - mean;
        const float s2 = wave_sum(dx * dx + dy * dy + dz * dz + dw * dw);
        const float rstd = rsqrtf(s2 * (1.0f / 256.0f) + EPS);
        float o0 = dx * rstd * g4.x + b4.x, o1 = dy * rstd * g4.y + b4.y, o2 = dz * rstd * g4.z + b4.z, o3 = dw * rstd * g4.w + b4.w;
        o0 *= sigmoidf_(o0); o1 *= sigmoidf_(o1); o2 *= sigmoidf_(o2); o3 *= sigmoidf_(o3);
        uint2 w; w.x = pk_bf16(o0, o1); w.y = pk_bf16(o2, o3);
        *(uint2*)(p.mixed + ((size_t)b * S + t0 + tl) * 1024 + 512 + lane * 4) = w;
    }
    __syncthreads();
}

__device__ void rnn1_item(const Params& p, int l, int item, char* smem) {
    float* sX = (float*)smem;
    float* sWr = sX + 67 * 64;
    float* sWi = sWr + 4096;
    float* sAg = sWi + 4096;
    const int hb = item & 3, j = (item >> 2) & 127, b = item >> 9, t0 = j * 64;
    const int tid = get_tid(), c = tid & 63, q = tid >> 6;
    const bf16_t* projb = p.proj + (size_t)b * S * NIN;
#pragma unroll
    for (int i = 0; i < 3; ++i) {
        const int r = (tid >> 3) + 32 * i, c8 = tid & 7;
        if (r < 67) {
            const int t = t0 - 3 + r;
            uint4 a = {0u, 0u, 0u, 0u};
            if (t >= 0) a = *(const uint4*)(projb + (size_t)t * NIN + R0 + hb * 64 + c8 * 8);
            float* d = sX + r * 64 + c8 * 8;
            d[0] = bflo(a.x); d[1] = bfhi(a.x); d[2] = bflo(a.y); d[3] = bfhi(a.y); d[4] = bflo(a.z); d[5] = bfhi(a.z); d[6] = bflo(a.w); d[7] = bfhi(a.w);
        }
    }
    {
        const float* wr = p.rg_w_r + ((size_t)l * 4 + hb) * 4096; const float* wi = p.rg_w_i + ((size_t)l * 4 + hb) * 4096;
#pragma unroll
        for (int i = 0; i < 16; ++i) { sWr[tid + 256 * i] = wr[tid + 256 * i]; sWi[tid + 256 * i] = wi[tid + 256 * i]; }
    }
    const int ch = hb * 64 + c;
    float cw[4];
#pragma unroll
    for (int k = 0; k < 4; ++k) cw[k] = p.rg_conv_w[((size_t)l * 4 + k) * 256 + ch];
    const float cb = p.rg_conv_b[l * 256 + ch];
    __syncthreads();
    float xc[16];
#pragma unroll
    for (int i = 0; i < 16; ++i) {
        const int tl = q * 16 + i;
        xc[i] = cb + cw[0] * sX[(tl + 0) * 64 + c] + cw[1] * sX[(tl + 1) * 64 + c] + cw[2] * sX[(tl + 2) * 64 + c] + cw[3] * sX[(tl + 3) * 64 + c];
    }
    __syncthreads();
#pragma unroll
    for (int i = 0; i < 16; ++i) sX[(q * 16 + i) * 64 + c] = xc[i];
    __syncthreads();
    float ar[16], ai[16];
#pragma unroll
    for (int i = 0; i < 16; ++i) { ar[i] = 0.f; ai[i] = 0.f; }
    for (int k = 0; k < 64; ++k) {
        const float wrv = sWr[k * 64 + c], wiv = sWi[k * 64 + c];
#pragma unroll
        for (int i = 0; i < 16; ++i) { const float xv = sX[(q * 16 + i) * 64 + k]; ar[i] += xv * wrv; ai[i] += xv * wiv; }
    }
    const float br = p.rg_b_r[l * 256 + ch], bi = p.rg_b_i[l * 256 + ch];
    const float lam = p.rg_lambda[l * 256 + ch];
    const float sp = log1p_pos(__expf(-lam));
    float hl[16], Pl[16];
    float hrun = 0.f, prun = 1.f;
#pragma unroll
    for (int i = 0; i < 16; ++i) {
        const float r = sigmoidf_(ar[i] + br), ig = sigmoidf_(ai[i] + bi);
        const float log_a = -8.0f * r * sp;
        const float a = __expf(log_a);
        const float mult = sqrtf(neg_expm1_neg(2.0f * log_a));
        const float bt = mult * ig * xc[i];
        hrun = a * hrun + bt; prun *= a;
        hl[i] = hrun; Pl[i] = prun;
    }
    sAg[q * 64 + c] = prun; sAg[256 + q * 64 + c] = hrun;
    __syncthreads();
    float carry = 0.f, pprev = 1.f;
    for (int qq = 0; qq < q; ++qq) { const float pe = sAg[qq * 64 + c], he = sAg[256 + qq * 64 + c]; carry = pe * carry + he; pprev *= pe; }
    unsigned* sHP = (unsigned*)sWr;
#pragma unroll
    for (int i = 0; i < 16; ++i) sHP[(q * 16 + i) * 64 + c] = pk_bf16(hl[i] + Pl[i] * carry, Pl[i] * pprev);
    if (q == 3) {
        const size_t o = ((size_t)b * 128 + j) * 256 + ch;
        *(f32x2*)(p.AB + 2 * o) = (f32x2){Pl[15] * pprev, hl[15] + Pl[15] * carry};
    }
    __syncthreads();
#pragma unroll
    for (int i = 0; i < 4; ++i) {
        const int tl = (tid >> 4) + 16 * i, c4 = (tid & 15) * 4;
        *(u32x4*)(p.HP + ((size_t)b * S + t0 + tl) * 256 + hb * 64 + c4) = *(const u32x4*)(sHP + tl * 64 + c4);
    }
    __syncthreads();
}

constexpr int ATT_BUF = 18688;
__device__ void attn_item(const Params& p, int s_idx, char* smem) {
    const int qb = 63 - (s_idx >> 5), bh = s_idx & 31, b = bh >> 3, h = bh & 7;
    const int tid = get_tid(), lane = tid & 63, wid = tid >> 6, ql = lane & 31, hh = lane >> 5;
    const int qrow = qb * 128 + wid * 32 + ql;
    const bf16_t* projb = p.proj + (size_t)b * S * NIN;
    bf16x8 qf[4];
#pragma unroll
    for (int kk = 0; kk < 4; ++kk) qf[kk] = *(const bf16x8*)(projb + (size_t)qrow * NIN + h * 64 + kk * 16 + hh * 8);
    f32x16 O0, O1;
#pragma unroll
    for (int i = 0; i < 16; ++i) { O0[i] = 0.f; O1[i] = 0.f; }
    float mrun = -INFINITY, lsum = 0.f;
    const int nkt = qb * 2 + 2;
    const int wave_last = (qb * 128 + wid * 32 + 31) >> 6;
    const int wave_q0 = qb * 128 + wid * 32;
    const float sc = 0.125f * LOG2E;
    struct KV { u32x4 rk[2], rv[2]; float rkb; };
    KV sa;
    auto gload = [&](int kt, KV& st) {
#pragma unroll
        for (int i = 0; i < 2; ++i) {
            const int c = tid + 256 * i, key = c >> 3, dc = c & 7;
            const bf16_t* src = projb + (size_t)(kt * 64 + key) * NIN + h * 64 + dc * 8;
            st.rk[i] = *(const u32x4*)(src + 512);
            const int keyv = c & 63, dcv = c >> 6;
            st.rv[i] = *(const u32x4*)(projb + (size_t)(kt * 64 + keyv) * NIN + 1024 + h * 64 + dcv * 8);
        }
        st.rkb = p.kb[(size_t)bh * S + kt * 64 + (tid & 63)];
    };
    auto sstore = [&](int buf, const KV& st) {
        bf16_t* sK = (bf16_t*)(smem + buf * ATT_BUF); bf16_t* sVt = sK + 64 * 72; float* sKb = (float*)(smem + buf * ATT_BUF + 18432);
#pragma unroll
        for (int i = 0; i < 2; ++i) {
            const int c = tid + 256 * i, key = c >> 3, dc = c & 7;
            *(u32x4*)(sK + key * 72 + dc * 8) = st.rk[i];
            const unsigned w0 = st.rv[i].x, w1 = st.rv[i].y, w2 = st.rv[i].z, w3 = st.rv[i].w;
            bf16_t* d = sVt + ((c >> 6) * 8) * 72 + (c & 63);
            d[0 * 72] = (bf16_t)(w0 & 0xffffu); d[1 * 72] = (bf16_t)(w0 >> 16);
            d[2 * 72] = (bf16_t)(w1 & 0xffffu); d[3 * 72] = (bf16_t)(w1 >> 16);
            d[4 * 72] = (bf16_t)(w2 & 0xffffu); d[5 * 72] = (bf16_t)(w2 >> 16);
            d[6 * 72] = (bf16_t)(w3 & 0xffffu); d[7 * 72] = (bf16_t)(w3 >> 16);
        }
        if (tid < 64) sKb[tid] = st.rkb;
    };
    const int pr = (ql & 0x13) | ((ql & 4) << 1) | ((ql & 8) >> 1);
    auto compute = [&](int kt, int buf) {
        if (kt <= wave_last) {
            const bf16_t* sK = (const bf16_t*)(smem + buf * ATT_BUF); const bf16_t* sVt = sK + 64 * 72; const float* sKb = (const float*)(smem + buf * ATT_BUF + 18432);
            f32x16 S0, S1;
#pragma unroll
            for (int i = 0; i < 16; ++i) { S0[i] = 0.f; S1[i] = 0.f; }
#pragma unroll
            for (int kk = 0; kk < 4; ++kk) {
                const bf16x8 k0 = *(const bf16x8*)(sK + pr * 72 + kk * 16 + hh * 8);
                const bf16x8 k1 = *(const bf16x8*)(sK + (32 + pr) * 72 + kk * 16 + hh * 8);
                S0 = __builtin_amdgcn_mfma_f32_32x32x16_bf16(k0, qf[kk], S0, 0, 0, 0);
                S1 = __builtin_amdgcn_mfma_f32_32x32x16_bf16(k1, qf[kk], S1, 0, 0, 0);
            }
            float sv[32];
#pragma unroll
            for (int g = 0; g < 4; ++g) {
                const int kbase = (g >> 1) * 32 + (g & 1) * 16 + 8 * hh;
                const float4 b0 = *(const float4*)(sKb + kbase), b1 = *(const float4*)(sKb + kbase + 4);
                const int o = (g & 1) * 8;
                if (g >> 1) {
                    sv[g * 8 + 0] = S1[o + 0] * sc + b0.x; sv[g * 8 + 1] = S1[o + 1] * sc + b0.y; sv[g * 8 + 2] = S1[o + 2] * sc + b0.z; sv[g * 8 + 3] = S1[o + 3] * sc + b0.w;
                    sv[g * 8 + 4] = S1[o + 4] * sc + b1.x; sv[g * 8 + 5] = S1[o + 5] * sc + b1.y; sv[g * 8 + 6] = S1[o + 6] * sc + b1.z; sv[g * 8 + 7] = S1[o + 7] * sc + b1.w;
                } else {
                    sv[g * 8 + 0] = S0[o + 0] * sc + b0.x; sv[g * 8 + 1] = S0[o + 1] * sc + b0.y; sv[g * 8 + 2] = S0[o + 2] * sc + b0.z; sv[g * 8 + 3] = S0[o + 3] * sc + b0.w;
                    sv[g * 8 + 4] = S0[o + 4] * sc + b1.x; sv[g * 8 + 5] = S0[o + 5] * sc + b1.y; sv[g * 8 + 6] = S0[o + 6] * sc + b1.z; sv[g * 8 + 7] = S0[o + 7] * sc + b1.w;
                }
            }
            if (kt * 64 + 63 > wave_q0) {
#pragma unroll
                for (int g = 0; g < 4; ++g) {
                    const int kbase = kt * 64 + (g >> 1) * 32 + (g & 1) * 16 + 8 * hh;
#pragma unroll
                    for (int e = 0; e < 8; ++e) if (kbase + e > qrow) sv[g * 8 + e] = -INFINITY;
                }
            }
            float mx = sv[0];
#pragma unroll
            for (int i = 1; i < 32; ++i) mx = fmaxf(mx, sv[i]);
            mx = fmaxf(mx, __shfl_xor(mx, 32));
            const float mnew = fmaxf(mrun, mx);
            const float alpha = __builtin_amdgcn_exp2f(mrun - mnew);
            mrun = mnew;
            float psum = 0.f;
#pragma unroll
            for (int i = 0; i < 32; ++i) { sv[i] = __builtin_amdgcn_exp2f(sv[i] - mnew); psum += sv[i]; }
            lsum = lsum * alpha + psum;
#pragma unroll
            for (int i = 0; i < 16; ++i) { O0[i] *= alpha; O1[i] *= alpha; }
#pragma unroll
            for (int g = 0; g < 4; ++g) {
                bf16x8 pf;
                {
                    const unsigned u0 = pk_bf16(sv[g * 8 + 0], sv[g * 8 + 1]), u1 = pk_bf16(sv[g * 8 + 2], sv[g * 8 + 3]);
                    const unsigned u2 = pk_bf16(sv[g * 8 + 4], sv[g * 8 + 5]), u3 = pk_bf16(sv[g * 8 + 6], sv[g * 8 + 7]);
                    const uint4 uu = {u0, u1, u2, u3};
                    pf = __builtin_bit_cast(bf16x8, uu);
                }
                const int koff = (g >> 1) * 32 + (g & 1) * 16 + 8 * hh;
                const bf16x8 v0 = *(const bf16x8*)(sVt + ql * 72 + koff);
                const bf16x8 v1 = *(const bf16x8*)(sVt + (32 + ql) * 72 + koff);
                O0 = __builtin_amdgcn_mfma_f32_32x32x16_bf16(v0, pf, O0, 0, 0, 0);
                O1 = __builtin_amdgcn_mfma_f32_32x32x16_bf16(v1, pf, O1, 0, 0, 0);
            }
        }
    };
    gload(0, sa); sstore(0, sa); __syncthreads();
    for (int kt = 0; kt < nkt; kt += 2) {
        gload(kt + 1, sa);
        compute(kt, 0);
        sstore(1, sa);
        __syncthreads();
        gload(min(kt + 2, nkt - 1), sa);
        compute(kt + 1, 1);
        if (kt + 2 < nkt) sstore(0, sa);
        __syncthreads();
    }
    const float ltot = lsum + __shfl_xor(lsum, 32);
    const float inv = 1.0f / ltot;
    bf16_t* sO = (bf16_t*)smem + wid * (32 * 72);
#pragma unroll
    for (int g = 0; g < 4; ++g) {
        uint2 w0, w1;
        w0.x = pk_bf16(O0[g * 4 + 0] * inv, O0[g * 4 + 1] * inv); w0.y = pk_bf16(O0[g * 4 + 2] * inv, O0[g * 4 + 3] * inv);
        w1.x = pk_bf16(O1[g * 4 + 0] * inv, O1[g * 4 + 1] * inv); w1.y = pk_bf16(O1[g * 4 + 2] * inv, O1[g * 4 + 3] * inv);
        *(uint2*)(sO + ql * 72 + 8 * g + 4 * hh) = w0;
        *(uint2*)(sO + ql * 72 + 32 + 8 * g + 4 * hh) = w1;
    }
    __builtin_amdgcn_wave_barrier();
    bf16_t* obase = p.mixed + ((size_t)b * S + qb * 128 + wid * 32) * 1024 + h * 64;
#pragma unroll
    for (int i = 0; i < 4; ++i) {
        const int r = (lane >> 3) + 8 * i, c8 = lane & 7;
        *(u32x4*)(obase + (size_t)r * 1024 + c8 * 8) = *(const u32x4*)(sO + r * 72 + c8 * 8);
    }
    __syncthreads();
}

__device__ void rnn2_item(const Params& p, int item, char* smem) {
    float* sCarry = (float*)smem;
    float* sSeg = sCarry + 64;
    const int hb = item & 3, j = (item >> 2) & 127, b = item >> 9, t0 = j * 64;
    const int tid = get_tid();
    {
        const int w = tid >> 6, c = tid & 63, j0 = (j * w) >> 2, j1 = (j * (w + 1)) >> 2;
        float a = 1.f, bb = 0.f;
        const f32x2* ab = (const f32x2*)p.AB + ((size_t)b * 128) * 256 + hb * 64 + c;
#pragma unroll 16
        for (int jp = j0; jp < j1; ++jp) { const f32x2 v = ab[(size_t)jp * 256]; bb = v.x * bb + v.y; a *= v.x; }
        sSeg[(w * 2 + 0) * 64 + c] = a; sSeg[(w * 2 + 1) * 64 + c] = bb;
    }
    __syncthreads();
    if (tid < 64) {
        float carry = sSeg[1 * 64 + tid];
#pragma unroll
        for (int w = 1; w < 4; ++w) carry = sSeg[(w * 2) * 64 + tid] * carry + sSeg[(w * 2 + 1) * 64 + tid];
        sCarry[tid] = carry;
    }
    __syncthreads();
    const int cc = tid & 7;
    const f32x4 ca = *(const f32x4*)(sCarry + cc * 8), cb = *(const f32x4*)(sCarry + cc * 8 + 4);
    const float cr[8] = {ca[0], ca[1], ca[2], ca[3], cb[0], cb[1], cb[2], cb[3]};
#pragma unroll
    for (int i = 0; i < 2; ++i) {
        const size_t t = (size_t)b * S + t0 + (tid >> 3) + 32 * i;
        const u32x4 h0 = *(const u32x4*)(p.HP + t * 256 + hb * 64 + cc * 8), h1 = *(const u32x4*)(p.HP + t * 256 + hb * 64 + cc * 8 + 4);
        const u32x4 gt = *(const u32x4*)(p.proj + t * NIN + G0 + hb * 64 + cc * 8);
        const unsigned hp[8] = {h0.x, h0.y, h0.z, h0.w, h1.x, h1.y, h1.z, h1.w};
        const unsigned gw[4] = {gt.x, gt.y, gt.z, gt.w};
        float o[8];
#pragma unroll
        for (int e = 0; e < 8; ++e) {
            const float hfull = bflo(hp[e]) + bfhi(hp[e]) * cr[e];
            const float gate = (e & 1) ? bfhi(gw[e >> 1]) : bflo(gw[e >> 1]);
            o[e] = hfull * gelu_tanh(gate);
        }
        u32x4 w; w.x = pk_bf16(o[0], o[1]); w.y = pk_bf16(o[2], o[3]); w.z = pk_bf16(o[4], o[5]); w.w = pk_bf16(o[6], o[7]);
        *(u32x4*)(p.mixed + t * 1024 + 768 + hb * 64 + cc * 8) = w;
    }
    __syncthreads();
}

__device__ __forceinline__ unsigned f2sort(float f) { const unsigned u = __float_as_uint(f); return (u & 0x80000000u) ? ~u : (u | 0x80000000u); }
__device__ __forceinline__ float sort2f(unsigned k) { const unsigned u = (k & 0x80000000u) ? (k & 0x7fffffffu) : ~k; return __uint_as_float(u); }

__device__ __forceinline__ void sort16_desc(unsigned (&v)[16]) {
#pragma unroll
    for (int k = 2; k <= 16; k <<= 1)
#pragma unroll
        for (int j = k >> 1; j > 0; j >>= 1)
#pragma unroll
            for (int i = 0; i < 16; ++i) {
                const int l = i ^ j;
                if (l > i) {
                    const unsigned a = v[i], b = v[l];
                    const bool desc = ((i & k) == 0) || (k == 16);
                    v[i] = desc ? max(a, b) : min(a, b);
                    v[l] = desc ? min(a, b) : max(a, b);
                }
            }
}
__device__ __forceinline__ void merge16_desc(unsigned (&top)[16], const unsigned (&c)[16]) {
#pragma unroll
    for (int i = 0; i < 16; ++i) top[i] = max(top[i], c[15 - i]);
#pragma unroll
    for (int j = 8; j > 0; j >>= 1)
#pragma unroll
        for (int i = 0; i < 16; ++i) {
            const int l = i ^ j;
            if (l > i) { const unsigned a = top[i], b = top[l]; top[i] = max(a, b); top[l] = min(a, b); }
        }
}

__device__ void topk_item(const Params& p, int wi, char* smem) {
    const int tid = get_tid(), lane = tid & 63, wid = tid >> 6;
    int* sIdx = (int*)smem + wid * 2048;
    const int head = wi & 7, tg = wi >> 3, t = tg * 64 + lane;
    float vals[2][16];
    {
        const f32x4* base = (const f32x4*)p.scT + ((size_t)tg * 512 + head * 64) * 64 + lane;
        f32x4 bufA[8], bufB[8];
        auto ldc = [&](int ch, f32x4 (&buf)[8]) {
#pragma unroll
            for (int q = 0; q < 8; ++q) buf[q] = __builtin_nontemporal_load(base + (ch * 8 + q) * 64);
        };
        unsigned top[16];
        auto ins = [&](int ch, const f32x4 (&buf)[8]) {
#pragma unroll
            for (int grp = 0; grp < 2; ++grp) {
                unsigned c[16];
#pragma unroll
                for (int q = 0; q < 4; ++q)
#pragma unroll
                    for (int e = 0; e < 4; ++e)
                        c[q * 4 + e] = (f2sort(buf[grp * 4 + q][e]) & ~127u) | (unsigned)(127 - ((ch & 3) * 32 + (grp * 4 + q) * 4 + e));
                sort16_desc(c);
                if ((ch & 3) == 0 && grp == 0) {
#pragma unroll
                    for (int i = 0; i < 16; ++i) top[i] = c[i];
                } else merge16_desc(top, c);
            }
        };
        auto fin = [&](int half) {
#pragma unroll
            for (int i = 0; i < 16; ++i) { vals[half][i] = sort2f(top[i] & ~127u); sIdx[(half * 16 + i) * 64 + lane] = 127 - (int)(top[i] & 127u); }
        };
        ldc(0, bufA); ldc(1, bufB);
        ins(0, bufA); ldc(2, bufA);
        ins(1, bufB); ldc(3, bufB);
        ins(2, bufA); ldc(4, bufA);
        ins(3, bufB); fin(0); ldc(5, bufB);
        ins(4, bufA); ldc(6, bufA);
        ins(5, bufB); ldc(7, bufB);
        ins(6, bufA);
        ins(7, bufB); fin(1);
    }
    unsigned top[16];
#pragma unroll
    for (int i = 0; i < 16; ++i) top[i] = 0u;
#pragma unroll
    for (int i = 0; i < 16; ++i)
#pragma unroll
        for (int j = 0; j < 16; ++j)
            if ((i + 1) * (j + 1) <= 16) {
                unsigned x = (f2sort(vals[0][i] + vals[1][j]) & ~255u) | (unsigned)(255 - (i * 16 + j));
#pragma unroll
                for (int q = 0; q < 16; ++q) { const unsigned hi = max(top[q], x); x = min(top[q], x); top[q] = hi; }
            }
    float g[16]; float gs = 0.f;
    const float mx = sort2f(top[0] & ~255u);
    int ex[16];
#pragma unroll
    for (int i = 0; i < 16; ++i) {
        g[i] = __expf(sort2f(top[i] & ~255u) - mx); gs += g[i];
        const int ci = 255 - (int)(top[i] & 255u);
        const int e1 = sIdx[(ci >> 4) * 64 + lane], e2 = sIdx[(16 + (ci & 15)) * 64 + lane];
        ex[i] = e1 * 128 + e2;
    }
    const float ginv = 1.0f / gs;
    int* ed = p.experts + (size_t)t * 128 + head * 16; float* gd = p.gates + (size_t)t * 128 + head * 16;
#pragma unroll
    for (int i = 0; i < 16; i += 4) {
        *(int4*)(ed + i) = make_int4(ex[i], ex[i + 1], ex[i + 2], ex[i + 3]);
        *(float4*)(gd + i) = make_float4(g[i] * ginv, g[i + 1] * ginv, g[i + 2] * ginv, g[i + 3] * ginv);
    }
}


constexpr int PEER_LDS_WAVE = 9472;
__device__ __forceinline__ float wave_max(float v) {
#pragma unroll
    for (int o = 32; o >= 1; o >>= 1) v = fmaxf(v, __shfl_xor(v, o));
    return v;
}
__device__ __forceinline__ void peer_u_phase(const Params& p, int l, int x, int wq, int nwq, int lane, int wid, char* smem) {
    const int g = lane >> 3, c = lane & 7, hl = lane >> 5, l32 = lane & 31;
    const int nb = (T / 8 - wq + nwq - 1) / nwq, ntok = nb * 8;
    int* sIds = (int*)(smem + wid * PEER_LDS_WAVE); unsigned char* sXq = (unsigned char*)(sIds + 1024); float* sSh = (float*)(sXq + 1024); float* sPart = sSh + 8;
    const float* ggp = p.norm2_g + l * 1024 + x * 128 + 4 * l32;
    const unsigned char* Ut = p.U8 + ((size_t)(l * 8 + x) * 16384) * 128;
    struct Meta { i32x4 id[4]; f32x4 xv[4]; float rs; };
    auto tok = [&](int k) { const int kk = k < ntok ? k : 0; return ((kk >> 3) * nwq + wq) * 8 + (kk & 7); };
    auto load_meta = [&](int b, Meta& m) {
#pragma unroll
        for (int jj = 0; jj < 4; ++jj) m.id[jj] = *(const i32x4*)(p.experts + (size_t)tok(b * 8 + 2 * jj + hl) * 128 + 4 * l32);
    };
    auto load_x = [&](int b, Meta& m) {
#pragma unroll
        for (int jj = 0; jj < 4; ++jj) m.xv[jj] = *(const f32x4*)(p.out + (size_t)tok(b * 8 + 2 * jj + hl) * 1024 + x * 128 + 4 * l32);
        m.rs = p.rstd2[tok(b * 8 + (lane & 7))];
    };
    auto store_meta = [&](const Meta& m) {
        const f32x4 gg = *(const f32x4*)ggp;
#pragma unroll
        for (int jj = 0; jj < 4; ++jj) {
            const int j = 2 * jj + hl;
            *(i32x4*)(sIds + j * 128 + 4 * l32) = m.id[jj];
            const float rs = __shfl(m.rs, j);
            const f32x4 h = m.xv[jj] * gg * rs;
            float am = fmaxf(fmaxf(fabsf(h[0]), fabsf(h[1])), fmaxf(fabsf(h[2]), fabsf(h[3])));
#pragma unroll
            for (int o = 16; o >= 1; o >>= 1) am = fmaxf(am, __shfl_xor(am, o));
            const float inv = am > 0.f ? 127.0f / am : 0.0f;
            const int q0 = __float2int_rn(h[0] * inv), q1 = __float2int_rn(h[1] * inv), q2 = __float2int_rn(h[2] * inv), q3 = __float2int_rn(h[3] * inv);
            *(unsigned*)(sXq + j * 128 + 4 * l32) = (unsigned)(q0 & 255) | ((unsigned)(q1 & 255) << 8) | ((unsigned)(q2 & 255) << 16) | ((unsigned)q3 << 24);
            if (l32 == 0) sSh[j] = am * (1.0f / 127.0f);
        }
    };
    auto issue = [&](int u, u32x4 (&rows)[8]) {
        const int* ip = sIds + (u >> 1) * 128 + g * 16 + (u & 1) * 8;
        const int4 a = *(const int4*)ip, b = *(const int4*)(ip + 4);
        const int e[8] = {a.x, a.y, a.z, a.w, b.x, b.y, b.z, b.w};
#pragma unroll
        for (int s = 0; s < 8; ++s) rows[s] = *(const u32x4*)(Ut + (unsigned)(e[s] * 128 + c * 16));
    };
    auto compute = [&](int u, const u32x4 (&rows)[8]) {
        const int j = u >> 1;
        const float sh = sSh[j];
        const u32x4 hq = *(const u32x4*)(sXq + j * 128 + c * 16);
        int part[8];
#pragma unroll
        for (int s = 0; s < 8; ++s) {
            int d = __builtin_amdgcn_sdot4((int)rows[s][0], (int)hq[0], 0, false);
            d = __builtin_amdgcn_sdot4((int)rows[s][1], (int)hq[1], d, false);
            d = __builtin_amdgcn_sdot4((int)rows[s][2], (int)hq[2], d, false);
            part[s] = __builtin_amdgcn_sdot4((int)rows[s][3], (int)hq[3], d, false);
        }
#pragma unroll
        for (int o = 4, n = 8; o >= 1; o >>= 1, n >>= 1) {
            const bool up = (lane & o) != 0;
#pragma unroll
            for (int i = 0; i < n / 2; ++i) {
                int lo = part[i], hi = part[i + n / 2];
                asm volatile("" : "+v"(lo), "+v"(hi));
                const int send = up ? lo : hi, keep = up ? hi : lo;
                part[i] = keep + __shfl_xor(send, o);
            }
        }
        sPart[j * 128 + g * 16 + (u & 1) * 8 + c] = (float)part[0] * sh;
    };
    Meta m; load_meta(0, m); load_x(0, m);
    for (int b = 0; b < nb; ++b) {
        __builtin_amdgcn_wave_barrier();
        store_meta(m);
        __builtin_amdgcn_wave_barrier();
        load_meta(min(b + 1, nb - 1), m);
        u32x4 rA[8], rB[8];
        issue(0, rA);
#pragma unroll
        for (int u = 0; u < 16; u += 2) {
            issue(u + 1, rB);
            compute(u, rA);
            if (u + 2 < 16) issue(u + 2, rA);
            if (u == 8) load_x(min(b + 1, nb - 1), m);
            compute(u + 1, rB);
        }
        __builtin_amdgcn_wave_barrier();
#pragma unroll
        for (int jj = 0; jj < 4; ++jj) {
            const int j = 2 * jj + hl, k = b * 8 + j;
            const f32x4 v = *(const f32x4*)(sPart + j * 128 + 4 * l32);
            if (k < ntok) __builtin_nontemporal_store(v, (f32x4*)(p.part + ((size_t)x * T + tok(k)) * 128 + 4 * l32));
        }
    }
}

__device__ __forceinline__ void peer_w_phase(const Params& p, int l) {
    const int tid = get_tid();
    for (size_t i = ((size_t)get_bid() * NTHREADS + tid) * 4; i < (size_t)T * 128; i += (size_t)gridDim.x * NTHREADS * 4) {
        f32x4 hs = __builtin_nontemporal_load((const f32x4*)(p.part + i));
#pragma unroll
        for (int xx = 1; xx < 8; ++xx) hs += __builtin_nontemporal_load((const f32x4*)(p.part + (size_t)xx * T * 128 + i));
        const int4 e = *(const int4*)(p.experts + i);
        const f32x4 gt = *(const f32x4*)(p.gates + i);
        const float* su = p.su + l * 16384; const float* sv = p.sv + l * 16384;
        f32x4 w;
        w[0] = gt[0] * gelu_tanh(hs[0] * su[e.x]) * sv[e.x]; w[1] = gt[1] * gelu_tanh(hs[1] * su[e.y]) * sv[e.y];
        w[2] = gt[2] * gelu_tanh(hs[2] * su[e.z]) * sv[e.z]; w[3] = gt[3] * gelu_tanh(hs[3] * su[e.w]) * sv[e.w];
        *(f32x4*)(p.wbuf + i) = w;
    }
}

__device__ __forceinline__ void peer_v_phase(const Params& p, int l, int x, int wq, int nwq, int lane, int wid, char* smem) {
    const int g = lane >> 3, c = lane & 7, hl = lane >> 5, l32 = lane & 31;
    const int nb = (T / 8 - wq + nwq - 1) / nwq, ntok = nb * 8;
    int* sIds = (int*)(smem + wid * PEER_LDS_WAVE); unsigned char* sWq = (unsigned char*)(sIds + 1024); float* sSw = (float*)(sWq + 1024); float* sOld = sSw + 8;
    const unsigned char* Vt = p.V8 + ((size_t)(l * 8 + x) * 16384) * 128;
    const int ocol = c * 16 + 4 * (g >> 1);
    struct Meta { i32x4 id[4]; f32x4 wv[4]; };
    auto tok = [&](int k) { const int kk = k < ntok ? k : 0; return ((kk >> 3) * nwq + wq) * 8 + (kk & 7); };
    auto load_meta = [&](int b, Meta& m) {
#pragma unroll
        for (int jj = 0; jj < 4; ++jj) {
            const int t = tok(b * 8 + 2 * jj + hl);
            m.id[jj] = *(const i32x4*)(p.experts + (size_t)t * 128 + 4 * l32);
            m.wv[jj] = *(const f32x4*)(p.wbuf + (size_t)t * 128 + 4 * l32);
        }
    };
    auto store_meta = [&](const Meta& m) {
#pragma unroll
        for (int jj = 0; jj < 4; ++jj) {
            const int j = 2 * jj + hl;
            *(i32x4*)(sIds + j * 128 + 4 * l32) = m.id[jj];
            const f32x4 w = m.wv[jj];
            float am = fmaxf(fmaxf(fabsf(w[0]), fabsf(w[1])), fmaxf(fabsf(w[2]), fabsf(w[3])));
#pragma unroll
            for (int o = 16; o >= 1; o >>= 1) am = fmaxf(am, __shfl_xor(am, o));
            const float inv = am > 0.f ? 127.0f / am : 0.0f;
            const int q0 = __float2int_rn(w[0] * inv), q1 = __float2int_rn(w[1] * inv), q2 = __float2int_rn(w[2] * inv), q3 = __float2int_rn(w[3] * inv);
            *(unsigned*)(sWq + j * 128 + 4 * l32) = (unsigned)(q0 & 255) | ((unsigned)(q1 & 255) << 8) | ((unsigned)(q2 & 255) << 16) | ((unsigned)q3 << 24);
            if (l32 == 0) sSw[j] = am * (1.0f / 127.0f);
        }
    };
    auto issue = [&](int u, u32x4 (&rows)[8]) {
        const int* ip = sIds + (u >> 1) * 128 + g * 16 + (u & 1) * 8;
        const int4 a = *(const int4*)ip, b = *(const int4*)(ip + 4);
        const int e[8] = {a.x, a.y, a.z, a.w, b.x, b.y, b.z, b.w};
#pragma unroll
        for (int s = 0; s < 8; ++s) rows[s] = *(const u32x4*)(Vt + (unsigned)(e[s] * 128 + c * 16));
    };
    int acc[16];
    f32x4 oldv;
    auto compute = [&](int u, const u32x4 (&rows)[8], int kbase) {
        const int j = u >> 1;
        if ((u & 1) == 0) {
#pragma unroll
            for (int i = 0; i < 16; ++i) acc[i] = 0;
            oldv = *(const f32x4*)(p.out + (size_t)tok(kbase + j) * 1024 + x * 128 + ocol);
        }
        const uint2 wq2 = *(const uint2*)(sWq + j * 128 + g * 16 + (u & 1) * 8);
#pragma unroll
        for (int hgrp = 0; hgrp < 2; ++hgrp) {
            const int wq4 = (int)(hgrp ? wq2.y : wq2.x);
#pragma unroll
            for (int q = 0; q < 4; ++q) {
                const unsigned r0 = rows[hgrp * 4 + 0][q], r1 = rows[hgrp * 4 + 1][q], r2 = rows[hgrp * 4 + 2][q], r3 = rows[hgrp * 4 + 3][q];
                const unsigned a = __builtin_amdgcn_perm(r1, r0, 0x05010400u), b = __builtin_amdgcn_perm(r1, r0, 0x07030602u);
                const unsigned cc = __builtin_amdgcn_perm(r3, r2, 0x05010400u), d = __builtin_amdgcn_perm(r3, r2, 0x07030602u);
                const unsigned c0 = __builtin_amdgcn_perm(cc, a, 0x05040100u), c1 = __builtin_amdgcn_perm(cc, a, 0x07060302u);
                const unsigned c2 = __builtin_amdgcn_perm(d, b, 0x05040100u), c3 = __builtin_amdgcn_perm(d, b, 0x07060302u);
                acc[4 * q + 0] = __builtin_amdgcn_sdot4((int)c0, wq4, acc[4 * q + 0], false);
                acc[4 * q + 1] = __builtin_amdgcn_sdot4((int)c1, wq4, acc[4 * q + 1], false);
                acc[4 * q + 2] = __builtin_amdgcn_sdot4((int)c2, wq4, acc[4 * q + 2], false);
                acc[4 * q + 3] = __builtin_amdgcn_sdot4((int)c3, wq4, acc[4 * q + 3], false);
            }
        }
        if (u & 1) {
            int part[16];
#pragma unroll
            for (int i = 0; i < 16; ++i) part[i] = acc[i];
#pragma unroll
            for (int o = 32, n = 16; o >= 16; o >>= 1, n >>= 1) {
                const bool up = (lane & o) != 0;
#pragma unroll
                for (int i = 0; i < n / 2; ++i) {
                    int lo = part[i], hi = part[i + n / 2];
                    asm volatile("" : "+v"(lo), "+v"(hi));
                    const int send = up ? lo : hi, keep = up ? hi : lo;
                    part[i] = keep + __shfl_xor(send, o);
                }
            }
#pragma unroll
            for (int i = 0; i < 4; ++i) part[i] += __shfl_xor(part[i], 8);
            const float sw = sSw[j];
            const int k = kbase + j;
            float sq = 0.f;
            if (k < ntok && (g & 1) == 0) {
                f32x4 o = oldv;
                o[0] += (float)part[0] * sw; o[1] += (float)part[1] * sw; o[2] += (float)part[2] * sw; o[3] += (float)part[3] * sw;
                const size_t oi = (size_t)tok(k) * 1024 + x * 128 + ocol;
                *(f32x4*)(p.out + oi) = o;
                uint2 wb; wb.x = pk_bf16(o[0], o[1]); wb.y = pk_bf16(o[2], o[3]);
                *(uint2*)(p.xb + oi) = wb;
                sq = o[0] * o[0] + o[1] * o[1] + o[2] * o[2] + o[3] * o[3];
            }
            sq = wave_sum(sq);
            if (k < ntok && lane == 0) p.ssqA[(size_t)x * T + tok(k)] = sq;
        }
    };
    Meta m; load_meta(0, m);
    for (int b = 0; b < nb; ++b) {
        __builtin_amdgcn_wave_barrier();
        store_meta(m);
        __builtin_amdgcn_wave_barrier();
        load_meta(min(b + 1, nb - 1), m);
        u32x4 rA[8], rB[8];
        issue(0, rA);
#pragma unroll
        for (int u = 0; u < 16; u += 2) {
            issue(u + 1, rB);
            compute(u, rA, b * 8);
            if (u + 2 < 16) issue(u + 2, rA);
            compute(u + 1, rB, b * 8);
        }
    }
}

__device__ __forceinline__ void final_norm_token(const Params& p, int t, int lane) {
    float* xr = p.out + (size_t)t * 1024;
    f32x4 v[4];
#pragma unroll
    for (int i = 0; i < 4; ++i) v[i] = *(const f32x4*)(xr + i * 256 + lane * 4);
    float ss = 0.f;
#pragma unroll
    for (int i = 0; i < 4; ++i) ss += v[i][0] * v[i][0] + v[i][1] * v[i][1] + v[i][2] * v[i][2] + v[i][3] * v[i][3];
    ss = wave_sum(ss);
    const float r = rsqrtf(ss * (1.0f / 1024.0f) + EPS);
#pragma unroll
    for (int i = 0; i < 4; ++i) { const f32x4 gg = *(const f32x4*)(p.final_g + i * 256 + lane * 4); *(f32x4*)(xr + i * 256 + lane * 4) = v[i] * r * gg; }
}


#define XB_TMO      128
#define XB_XCNT(j)  (256  + 64 * (j))
#define XB_XSUB(j)  (1280 + 64 * (j))
#define XB_XGEN(j)  (2304 + 64 * (j))
#define XB_TOP      3328
#define XB_TOPGEN   3392
#define XCD_BAR_WORDS 3456
#define XB_SPIN_CAP (1u << 22)
#define LAS __attribute__((address_space(3)))
__device__ __forceinline__ unsigned xb_ld(unsigned* p)              { return __hip_atomic_load(p, __ATOMIC_RELAXED, __HIP_MEMORY_SCOPE_AGENT); }
__device__ __forceinline__ unsigned xb_add(unsigned* p, unsigned v) { return __hip_atomic_fetch_add(p, v, __ATOMIC_RELAXED, __HIP_MEMORY_SCOPE_AGENT); }
__device__ __forceinline__ unsigned xb_xcc_id() { return (unsigned)__builtin_amdgcn_s_getreg((3 << 11) | 20) & 0xFu; }
#define XB_SPIN(cond, bar) do { unsigned _sp = 0; while (cond) { __builtin_amdgcn_s_sleep(1); \
    if ((++_sp & 255u) == 0u) { if (xb_ld(&(bar)[XB_TMO])) break; if (_sp > XB_SPIN_CAP) { atomicAdd(&(bar)[XB_TMO], 1u); break; } } } } while (0)
struct XcdBarrier { unsigned* bar; unsigned x; volatile LAS unsigned* st; };
__device__ __forceinline__ XcdBarrier xcd_barrier_post(unsigned* bar, volatile LAS unsigned* st) {
    XcdBarrier b; b.bar = bar; b.x = xb_xcc_id(); b.st = st;
    if (threadIdx.x == 0) (void)xb_add(&bar[XB_XCNT(b.x)], 1u);
    return b;
}
__device__ __forceinline__ void xcd_barrier_complete(unsigned* bar, unsigned x, unsigned& nloc, unsigned& nx) {
    const unsigned G = gridDim.x * gridDim.y * gridDim.z;
    unsigned sum, cnt, mine, sp = 0u;
    for (;;) {
        sum = 0u; cnt = 0u; mine = 0u;
#pragma unroll
        for (unsigned j = 0; j < 16; ++j) { const unsigned c = xb_ld(&bar[XB_XCNT(j)]); sum += c; cnt += (c > 0u) ? 1u : 0u; mine = (j == x) ? c : mine; }
        if (sum == G) break;
        __builtin_amdgcn_s_sleep(1);
        if ((++sp & 255u) == 0u) { if (xb_ld(&bar[XB_TMO])) break; if (sp > XB_SPIN_CAP) { atomicAdd(&bar[XB_TMO], 1u); break; } }
    }
    nloc = mine > 0u ? mine : 1u; nx = cnt > 0u ? cnt : 1u;
}
__device__ __forceinline__ void xcd_barrier(const XcdBarrier& b) {
    asm volatile("s_waitcnt vmcnt(0)" ::: "memory");
    __syncthreads();
    if (threadIdx.x == 0) {
        unsigned* bar = b.bar;
        __builtin_amdgcn_s_waitcnt(0);
        unsigned nloc = b.st[0], nx = b.st[1];
        if (nloc == 0u) { xcd_barrier_complete(bar, b.x, nloc, nx); b.st[0] = nloc; b.st[1] = nx; }
        const unsigned old = xb_add(&bar[XB_XSUB(b.x)], 1u);
        const unsigned gen = old / nloc;
        if (old + 1u == (gen + 1u) * nloc) {
            __builtin_amdgcn_fence(__ATOMIC_RELEASE, "agent");
            asm volatile("s_waitcnt vmcnt(0)" ::: "memory");
            const unsigned og = xb_add(&bar[XB_TOP], 1u);
            const unsigned tg = og / nx;
            if (og + 1u == (tg + 1u) * nx) xb_add(&bar[XB_TOPGEN], 1u);
            else XB_SPIN(xb_ld(&bar[XB_TOPGEN]) == tg, bar);
            __builtin_amdgcn_fence(__ATOMIC_ACQUIRE, "agent");
            xb_add(&bar[XB_XGEN(b.x)], 1u);
            asm volatile("s_waitcnt vmcnt(0)" ::: "memory");
        } else {
            XB_SPIN(xb_ld(&bar[XB_XGEN(b.x)]) == gen, bar);
            __builtin_amdgcn_fence(__ATOMIC_ACQUIRE, "agent");
            asm volatile("s_waitcnt vmcnt(0)" ::: "memory");
        }
    }
    __syncthreads();
}

__device__ void run_phase(const Params& p, int ph, char* smem) {
    if (ph == 0) { phase_prep(p, smem); return; }
    if (ph == 19) {
        const int tid = get_tid(), wid = __builtin_amdgcn_readfirstlane(tid >> 6), lane = tid & 63;
        for (int t = get_bid() * 4 + wid; t < T; t += gridDim.x * 4) final_norm_token(p, t, lane);
        return;
    }
    const int l = (ph - 1) / 9, s = (ph - 1) % 9;
    if (s == 0) {
        EpiInProj epi{&p, l};
        int tm, tn;
        while (gemm_ticket(p.ctr + (l * 3 + 0) * 256, 21, tm, tn, smem)) gemm_tile64(p.xb, p.WinT + (size_t)l * NINP * 1024, tm, tn, epi, smem, p.ssqA, l == 0 ? 1 : 8);
    } else if (s == 1) {
        for (int it = get_bid(); it < 32; it += gridDim.x) cumsum_item(p, it, smem);
        for (int it = gridDim.x - 1 - get_bid(); it < 2048; it += gridDim.x) conv_item(p, l, it, smem);
        for (int it = get_bid(); it < 2048; it += gridDim.x) rnn1_item(p, l, it, smem);
    } else if (s == 2) {
        const bool quant_first = ((((unsigned)get_bid() >> 8) ^ (unsigned)get_bid()) & 1u) != 0u;
        const int G = gridDim.x, nr = (2048 + G - 1) / G;
        const int nq = (16384 + G - 1) / G, qper = (nq + nr - 1) / nr;
        auto do_quant = [&](int chunk) {
            const int qt = get_tid();
            for (int i = chunk * qper; i < (chunk + 1) * qper && i < nq; ++i) {
                const int j = i * G + get_bid();
                if (j < 16384) {
                    const int row = (j & 8191) * 4 + (qt >> 6);
                    if (j < 8192) prep_fp8_row(p.pu, p.U8, p.su, row, qt & 63); else prep_fp8_row(p.pv, p.V8, p.sv, row, qt & 63);
                }
            }
        };
        for (int r = 0; r < nr; ++r) {
            if (l == 0 && quant_first) do_quant(r);
            const int pos = (r & 1) ? (G - 1 - get_bid()) : get_bid();
            const int si = r * G + pos;
            if (si < 2048) attn_item(p, si, smem);
            if (l == 0 && !quant_first) do_quant(r);
        }
        for (int it = get_bid(); it < 2048; it += gridDim.x) rnn2_item(p, it, smem);
    } else if (s == 3) {
        EpiOutProj epi{l == 0 ? p.x : (const float*)p.out, p.out, p.xb, p.ssqE};
        int tm, tn;
        while (gemm_ticket(p.ctr + (l * 3 + 1) * 256, 8, tm, tn, smem)) gemm_tile64(p.mixed, p.WoutT + (size_t)l * 1024 * 1024, tm, tn, epi, smem, nullptr, 0);
    } else if (s == 4) {
        EpiScores epi{p.scT, p.rstd2};
        int tm, tn;
        while (gemm_ticket(p.ctr + (l * 3 + 2) * 256, 16, tm, tn, smem)) gemm_tile64(p.xb, p.WcT + (size_t)l * 2048 * 1024, tm, tn, epi, smem, p.ssqE, 16);
    } else if (s == 5) {
        const int wid = get_tid() >> 6;
        for (int it = get_bid(); it < 1024; it += gridDim.x) topk_item(p, it * 4 + wid, smem);
    } else {
        if (s == 7) { peer_w_phase(p, l); return; }
        const int tid = get_tid(), wu = __builtin_amdgcn_readfirstlane(tid >> 6), lane = tid & 63;
        const int x = get_bid() & 7, wq = (get_bid() >> 3) * 4 + wu, nwq = (gridDim.x >> 3) * 4;
        if (s == 6) peer_u_phase(p, l, x, wq, nwq, lane, wu, smem);
        else        peer_v_phase(p, l, x, wq, nwq, lane, wu, smem);
    }
}

__global__ void __launch_bounds__(NTHREADS, 3) mega_kernel(Params p, int ph0, int ph1) {
    __shared__ __attribute__((aligned(16))) char smem[SMEM_BYTES];
    __shared__ __attribute__((aligned(16))) unsigned xb_st[4];
    cg::grid_group grid = cg::this_grid();
    if (threadIdx.x < 4) xb_st[threadIdx.x] = 0u;
    __syncthreads();
    const XcdBarrier xb = xcd_barrier_post(p.bar, (volatile LAS unsigned*)xb_st);
    int ph = ph0, rep = 0;
    while (ph < ph1) {
        run_phase(p, ph, smem);
#ifdef REP_MASK
        const bool again = rep == 0 && ph >= 1 && ph <= 18 && ((REP_MASK >> ((ph - 1) % 9)) & 1);
#else
        const bool again = false;
#endif
        if (again) rep = 1; else { rep = 0; ++ph; }
        if (ph < ph1) { if (ph == 1 && rep == 0) grid.sync(); else xcd_barrier(xb); }
    }
}

extern "C" void kernel_launch(void* const* d_in, const int* in_sizes, int n_in, void* d_out, int out_size, void* d_ws, size_t ws_size, hipStream_t stream) {
    Params p{};
    const float* const* in = (const float* const*)d_in;
    p.x = in[0]; p.norm1_g = in[1]; p.w_in = in[2]; p.b_forget = in[3]; p.conv_w = in[4]; p.conv_b = in[5]; p.ln_g = in[6]; p.ln_b = in[7];
    p.rg_conv_w = in[8]; p.rg_conv_b = in[9]; p.rg_w_r = in[10]; p.rg_b_r = in[11]; p.rg_w_i = in[12]; p.rg_b_i = in[13]; p.rg_lambda = in[14];
    p.w_out = in[15]; p.norm2_g = in[16]; p.wq = in[17]; p.k1 = in[18]; p.k2 = in[19]; p.pu = in[20]; p.pv = in[21]; p.final_g = in[22];
    p.out = (float*)d_out;
    char* w = (char*)d_ws; size_t off = 0;
    auto take = [&](size_t bytes) { char* r = w + off; off += (bytes + 255) & ~(size_t)255; return r; };
    p.WinT = (bf16_t*)take((size_t)2 * NINP * 1024 * 2);
    p.WoutT = (bf16_t*)take((size_t)2 * 1024 * 1024 * 2);
    p.WcT = (bf16_t*)take((size_t)2 * 2048 * 1024 * 2);
    p.U8 = (unsigned char*)take((size_t)2 * 16384 * 1024);
    p.V8 = (unsigned char*)take((size_t)2 * 16384 * 1024);
    p.su = (float*)take((size_t)2 * 16384 * 4);
    p.sv = (float*)take((size_t)2 * 16384 * 4);
    p.ctr = (unsigned*)take(6 * 256 * 4);
    p.bar = (unsigned*)take(XCD_BAR_WORDS * 4);
    p.rstd2 = (float*)take((size_t)T * 4);
    p.xb = (bf16_t*)take((size_t)T * 1024 * 2);
    p.ssqA = (float*)take((size_t)8 * T * 4);
    p.ssqE = (float*)take((size_t)16 * T * 4);
    p.wbuf = (float*)take((size_t)T * 128 * 4);
    p.logf = (float*)take((size_t)T * 8 * 4);
    p.kb = (float*)take((size_t)T * 8 * 4);
    p.Aagg = (float*)take((size_t)4 * 128 * 256 * 4);
    p.Bagg = (float*)take((size_t)4 * 128 * 256 * 4);
    p.experts = (int*)take((size_t)T * 128 * 4);
    p.gates = (float*)take((size_t)T * 128 * 4);
    char* r1 = take(0);
    p.proj = (bf16_t*)take((size_t)T * NIN * 2);
    p.mixed = (bf16_t*)take((size_t)T * 1024 * 2);
    p.hloc = (bf16_t*)take((size_t)T * 256 * 2);
    p.Pc = (bf16_t*)take((size_t)T * 256 * 2);
    p.HP = (unsigned*)p.hloc;
    p.AB = p.Aagg;
    p.scT = (float*)r1;
    p.part = (float*)r1;
    if (off > ws_size) { fprintf(stderr, "workspace too small: need %zu have %zu\n", off, ws_size); }

    static int grid_blocks = 0;
    if (!grid_blocks) {
        int dev = 0, cus = 0, per_cu = 0;
        hipGetDevice(&dev);
        hipDeviceGetAttribute(&cus, hipDeviceAttributeMultiprocessorCount, dev);
        hipOccupancyMaxActiveBlocksPerMultiprocessor(&per_cu, mega_kernel, NTHREADS, 0);
        if (per_cu > 3) per_cu = 3;
        if (per_cu < 1) per_cu = 1;
        grid_blocks = cus * per_cu;
        grid_blocks &= ~7;
    }
    hipMemsetAsync(p.ctr, 0, 6 * 256 * 4 + XCD_BAR_WORDS * 4, stream);
    int ph0 = 0, ph1 = 20;
    void* args[] = {&p, &ph0, &ph1};
    hipError_t e = hipLaunchCooperativeKernel((void*)mega_kernel, dim3(grid_blocks), dim3(NTHREADS), args, 0, stream);
    if (e != hipSuccess) fprintf(stderr, "cooperative launch failed: %s (grid %d)\n", hipGetErrorString(e), grid_blocks);
}
```

```cpp
#include <hip/hip_runtime.h>
#include <hip/hip_cooperative_groups.h>
#include <cstdint>
#include <cstdio>
namespace cg = cooperative_groups;

typedef unsigned short bf16_t;
typedef short bf16x8 __attribute__((ext_vector_type(8)));
typedef float f32x4 __attribute__((ext_vector_type(4)));
typedef float f32x16 __attribute__((ext_vector_type(16)));
typedef float f32x2 __attribute__((ext_vector_type(2)));
typedef __bf16 v2bf __attribute__((ext_vector_type(2)));
typedef unsigned u32x4 __attribute__((ext_vector_type(4)));
typedef int i32x4 __attribute__((ext_vector_type(4)));

constexpr int T = 32768, D = 1024, S = 8192;
constexpr int NIN = 2568, NINP = 2688;
constexpr int F0 = 1536, C0 = 1544, R0 = 2056, G0 = 2312;
constexpr float EPS = 1e-6f;
constexpr float LOG2E = 1.4426950408889634f;
constexpr int NTHREADS = 256;
constexpr int SMEM_BYTES = 52224;

struct Params {
    const float *x, *norm1_g, *w_in, *b_forget, *conv_w, *conv_b, *ln_g, *ln_b;
    const float *rg_conv_w, *rg_conv_b, *rg_w_r, *rg_b_r, *rg_w_i, *rg_b_i, *rg_lambda;
    const float *w_out, *norm2_g, *wq, *k1, *k2, *pu, *pv, *final_g;
    float* out;
    bf16_t *WinT, *WoutT, *WcT, *proj, *mixed, *hloc, *Pc;
    unsigned* HP; float* AB;
    unsigned char *U8, *V8;
    float *su, *sv;
    float *logf, *kb, *Aagg, *Bagg, *scT, *gates, *rstd2, *part, *wbuf;
    bf16_t* xb;
    float *ssqA, *ssqE;
    int* experts;
    unsigned* ctr; unsigned* bar;
};

__device__ __forceinline__ unsigned pk_bf16(float lo, float hi) { unsigned r; asm("v_cvt_pk_bf16_f32 %0, %1, %2" : "=v"(r) : "v"(lo), "v"(hi)); return r; }
__device__ __forceinline__ bf16_t f2bf(float f) { return (bf16_t)(pk_bf16(f, 0.f) & 0xffffu); }
__device__ __forceinline__ float bf2f(bf16_t b) { return __uint_as_float(((unsigned)b) << 16); }
__device__ __forceinline__ float bflo(unsigned u) { return __uint_as_float(u << 16); }
__device__ __forceinline__ float bfhi(unsigned u) { return __uint_as_float(u & 0xffff0000u); }
__device__ __forceinline__ float sigmoidf_(float x) { return 1.0f / (1.0f + __expf(-x)); }
__device__ __forceinline__ float gelu_tanh(float x) { const float u = 0.7978845608028654f * (x + 0.044715f * x * x * x); return x / (1.0f + __expf(-2.0f * u)); }
__device__ __forceinline__ int get_tid() { int t = threadIdx.x; asm volatile("" : "+v"(t)); return t; }
__device__ __forceinline__ int get_bid() { int b = blockIdx.x; asm volatile("" : "+s"(b)); return b; }
__device__ __forceinline__ float log1p_pos(float x) { return x < 0.0625f ? x * (1.0f - x * (0.5f - x * (0.33333334f - x * (0.25f - x * 0.2f)))) : __logf(1.0f + x); }
__device__ __forceinline__ float neg_expm1_neg(float y) { return y > -0.25f ? -y * (1.0f + 0.5f * y * (1.0f + 0.33333334f * y * (1.0f + 0.25f * y * (1.0f + 0.2f * y * (1.0f + 0.16666667f * y))))) : 1.0f - __expf(y); }
__device__ __forceinline__ float wave_sum(float v) {
#pragma unroll
    for (int o = 32; o >= 1; o >>= 1) v += __shfl_xor(v, o);
    return v;
}

__device__ void prep_transpose(const float* src, int ldn, int nvalid, const float* g, bf16_t* dst, int kt, int nt, char* smem) {
    float* sm = (float*)smem;
    const int tid = get_tid(), col = tid & 63, r0 = tid >> 6;
#pragma unroll 4
    for (int i = 0; i < 16; ++i) {
        const int row = r0 + 4 * i, k = kt * 64 + row, n = nt * 64 + col;
        float v = 0.f;
        if (n < nvalid) { v = src[(size_t)k * ldn + n]; if (g) v *= g[k]; }
        sm[row * 65 + col] = v;
    }
    __syncthreads();
#pragma unroll 4
    for (int i = 0; i < 16; ++i) {
        const int nl = r0 + 4 * i;
        dst[(size_t)(nt * 64 + nl) * 1024 + kt * 64 + col] = f2bf(sm[col * 65 + nl]);
    }
    __syncthreads();
}

__device__ void prep_wc(const Params& p, int l, int item, char* smem) {
    float* sK = (float*)smem;
    float* sW = sK + 64 * 65;
    const int dt = item & 15, jt = (item >> 4) & 1, hp = item >> 5, h = hp >> 1, pp = hp & 1;
    const float* Kp = (pp ? p.k2 : p.k1) + ((size_t)(l * 8 + h) * 128) * 128;
    const float* Wq = p.wq + (size_t)l * 1024 * 2048 + h * 256 + pp * 128;
    const int tid = get_tid(), cl = tid & 63, r0 = tid >> 6, tx = tid & 15, ty = tid >> 4;
    float acc[4][4];
#pragma unroll
    for (int a = 0; a < 4; ++a)
#pragma unroll
        for (int b = 0; b < 4; ++b) acc[a][b] = 0.f;
    for (int ch = 0; ch < 2; ++ch) {
#pragma unroll 4
        for (int i = 0; i < 16; ++i) {
            const int rl = r0 + 4 * i;
            sK[rl * 65 + cl] = Kp[(size_t)(jt * 64 + rl) * 128 + ch * 64 + cl];
            sW[rl * 65 + cl] = Wq[(size_t)(dt * 64 + rl) * 2048 + ch * 64 + cl];
        }
        __syncthreads();
#pragma unroll 8
        for (int c = 0; c < 64; ++c) {
            float kv[4], wv[4];
#pragma unroll
            for (int a = 0; a < 4; ++a) { kv[a] = sK[(ty * 4 + a) * 65 + c]; wv[a] = sW[(tx * 4 + a) * 65 + c]; }
#pragma unroll
            for (int a = 0; a < 4; ++a)
#pragma unroll
                for (int b = 0; b < 4; ++b) acc[a][b] += kv[a] * wv[b];
        }
        __syncthreads();
    }
    const float* g2 = p.norm2_g + l * 1024 + dt * 64 + tx * 4;
    const float g0 = g2[0], g1 = g2[1], g2v = g2[2], g3 = g2[3];
#pragma unroll
    for (int a = 0; a < 4; ++a) {
        const int n = hp * 128 + jt * 64 + ty * 4 + a;
        uint2 w; w.x = pk_bf16(acc[a][0] * g0, acc[a][1] * g1); w.y = pk_bf16(acc[a][2] * g2v, acc[a][3] * g3);
        *(uint2*)(p.WcT + ((size_t)l * 2048 + n) * 1024 + dt * 64 + tx * 4) = w;
    }
}

__device__ void prep_fp8_row(const float* src, unsigned char* dst8, float* scale, int row  , int lane) {
    const float* r = src + (size_t)row * 1024 + lane * 16;
    f32x4 v[4];
#pragma unroll
    for (int i = 0; i < 4; ++i) v[i] = __builtin_nontemporal_load((const f32x4*)(r + 4 * i));
    float am = 0.f;
#pragma unroll
    for (int i = 0; i < 4; ++i) am = fmaxf(am, fmaxf(fmaxf(fabsf(v[i][0]), fabsf(v[i][1])), fmaxf(fabsf(v[i][2]), fabsf(v[i][3]))));
#pragma unroll
    for (int o = 32; o >= 1; o >>= 1) am = fmaxf(am, __shfl_xor(am, o));
    const float sc = am > 0.f ? am * (1.0f / 127.0f) : 1.0f, inv = am > 0.f ? 127.0f / am : 0.0f;
    u32x4 w;
#pragma unroll
    for (int i = 0; i < 4; ++i) {
        const int q0 = __float2int_rn(v[i][0] * inv), q1 = __float2int_rn(v[i][1] * inv), q2 = __float2int_rn(v[i][2] * inv), q3 = __float2int_rn(v[i][3] * inv);
        w[i] = (unsigned)(q0 & 255) | ((unsigned)(q1 & 255) << 8) | ((unsigned)(q2 & 255) << 16) | ((unsigned)q3 << 24);
    }
    const int l = row >> 14, e = row & 16383, x = lane >> 3, c = lane & 7;
    *(u32x4*)(dst8 + ((size_t)(l * 8 + x) * 16384 + e) * 128 + c * 16) = w;
    if (lane == 0) scale[row] = sc;
}

__device__ void prep_x_row(const Params& p, int t, int lane) {
    const float* xr = p.x + (size_t)t * 1024;
    float ss = 0.f;
#pragma unroll
    for (int i = 0; i < 2; ++i) {
        const f32x4 a = *(const f32x4*)(xr + i * 512 + lane * 8), b = *(const f32x4*)(xr + i * 512 + lane * 8 + 4);
        ss += a[0] * a[0] + a[1] * a[1] + a[2] * a[2] + a[3] * a[3] + b[0] * b[0] + b[1] * b[1] + b[2] * b[2] + b[3] * b[3];
        u32x4 w; w.x = pk_bf16(a[0], a[1]); w.y = pk_bf16(a[2], a[3]); w.z = pk_bf16(b[0], b[1]); w.w = pk_bf16(b[2], b[3]);
        *(u32x4*)(p.xb + (size_t)t * 1024 + i * 512 + lane * 8) = w;
    }
    ss = wave_sum(ss);
    if (lane == 0) p.ssqA[t] = ss;
}

__device__ void phase_prep(const Params& p, char* smem) {
    { const int tid = get_tid(); for (int t = get_bid() * 4 + (tid >> 6); t < T; t += gridDim.x * 4) prep_x_row(p, t, tid & 63); }
    for (int it = get_bid(); it < 2880; it += gridDim.x) {
        if (it < 1344) { const int l = it / 672, r = it % 672, kt = r / 42, nt = r % 42;
            prep_transpose(p.w_in + (size_t)l * 1024 * NIN, NIN, NIN, p.norm1_g + l * 1024, p.WinT + (size_t)l * NINP * 1024, kt, nt, smem);
        } else if (it < 1856) { const int j = it - 1344, l = j / 256, r = j % 256, kt = r / 16, nt = r % 16;
            prep_transpose(p.w_out + (size_t)l * 1024 * 1024, 1024, 1024, nullptr, p.WoutT + (size_t)l * 1024 * 1024, kt, nt, smem);
        } else if (it < 2880) { const int j = it - 1856; prep_wc(p, j / 512, j % 512, smem);
        }
    }
}

template <int AF32, int SWAP, class Epi>
__device__ __forceinline__ void gemm_tile(const void* Aptr, const bf16_t* Bt, int tm, int tn, const Epi& epi, char* smem, const float* ssq = nullptr, int nparts = 0) {
    constexpr int K = 1024;
    bf16_t* sA = (bf16_t*)smem;
    bf16_t* sB = sA + 2 * 4096;
    float* sRs = (float*)(smem + 32768);
    const int tid = get_tid(), lane = tid & 63, wid = tid >> 6, wr = wid >> 1, wc = wid & 1, fr = lane & 15, fq = lane >> 4;
    f32x4 acc[4][4];
#pragma unroll
    for (int m = 0; m < 4; ++m)
#pragma unroll
        for (int n = 0; n < 4; ++n) acc[m][n] = (f32x4){0.f, 0.f, 0.f, 0.f};
    float ss[4] = {0.f, 0.f, 0.f, 0.f};
    struct Stage { f32x4 ra[4]; u32x4 rab[2]; u32x4 rb[2]; };
    Stage st0, st1;
    const float* Af = (const float*)Aptr + (size_t)tm * 128 * K;
    const bf16_t* Ab = (const bf16_t*)Aptr + (size_t)tm * 128 * K;
    const bf16_t* Bp = Bt + (size_t)tn * 128 * K;
    auto gload = [&](int kt, Stage& st) {
        if (AF32) {
#pragma unroll
            for (int i = 0; i < 4; ++i) st.ra[i] = *(const f32x4*)(Af + (size_t)((tid >> 3) + 32 * i) * K + kt * 32 + (tid & 7) * 4);
        } else {
#pragma unroll
            for (int i = 0; i < 2; ++i) { const int c = tid + 256 * i; st.rab[i] = *(const u32x4*)(Ab + (size_t)(c >> 2) * K + kt * 32 + (c & 3) * 8); }
        }
#pragma unroll
        for (int i = 0; i < 2; ++i) { const int c = tid + 256 * i; st.rb[i] = *(const u32x4*)(Bp + (size_t)(c >> 2) * K + kt * 32 + (c & 3) * 8); }
    };
    auto sstore = [&](int buf, const Stage& st) {
        if (AF32) {
#pragma unroll
            for (int i = 0; i < 4; ++i) {
                const f32x4 v = st.ra[i];
                ss[i] += v.x * v.x + v.y * v.y + v.z * v.z + v.w * v.w;
                uint2 w; w.x = pk_bf16(v.x, v.y); w.y = pk_bf16(v.z, v.w);
                { const int r = (tid >> 3) + 32 * i, hc = tid & 7; *(uint2*)(sA + buf * 4096 + r * 32 + (((hc >> 1) ^ ((r >> 2) & 3)) * 8) + (hc & 1) * 4) = w; }
            }
        } else {
#pragma unroll
            for (int i = 0; i < 2; ++i) { const int c = tid + 256 * i, r = c >> 2; *(u32x4*)(sA + buf * 4096 + r * 32 + ((c & 3) ^ ((r >> 2) & 3)) * 8) = st.rab[i]; }
        }
#pragma unroll
        for (int i = 0; i < 2; ++i) { const int c = tid + 256 * i, r = c >> 2; *(u32x4*)(sB + buf * 4096 + r * 32 + ((c & 3) ^ ((r >> 2) & 3)) * 8) = st.rb[i]; }
    };
    auto compute = [&](int buf) {
        bf16x8 af[4], bfr[4];
#pragma unroll
        for (int m = 0; m < 4; ++m) { const int r = wr * 64 + m * 16 + fr; af[m] = *(const bf16x8*)(sA + buf * 4096 + r * 32 + (fq ^ ((r >> 2) & 3)) * 8); }
#pragma unroll
        for (int n = 0; n < 4; ++n) { const int r = wc * 64 + (SWAP ? ((fr >> 2) * 16 + n * 4 + (fr & 3)) : (n * 16 + fr)); bfr[n] = *(const bf16x8*)(sB + buf * 4096 + r * 32 + (fq ^ ((r >> 2) & 3)) * 8); }
#pragma unroll
        for (int m = 0; m < 4; ++m)
#pragma unroll
            for (int n = 0; n < 4; ++n)
                acc[m][n] = SWAP ? __builtin_amdgcn_mfma_f32_16x16x32_bf16(bfr[n], af[m], acc[m][n], 0, 0, 0)
                                 : __builtin_amdgcn_mfma_f32_16x16x32_bf16(af[m], bfr[n], acc[m][n], 0, 0, 0);
    };
    if (nparts > 0 && tid < 128) {
        float sq = 0.f;
        for (int q = 0; q < nparts; ++q) sq += ssq[(size_t)q * T + (size_t)tm * 128 + tid];
        sRs[tid] = rsqrtf(sq * (1.0f / 1024.0f) + EPS);
    }
    gload(0, st0); sstore(0, st0); gload(1, st1); __syncthreads();
    for (int kt = 0; kt < 32; kt += 2) {
        gload(min(kt + 2, 31), st0);
        compute(0);
        sstore(1, st1);
        __syncthreads();
        gload(min(kt + 3, 31), st1);
        compute(1);
        if (kt + 2 < 32) sstore(0, st0);
        __syncthreads();
    }
    if (AF32) {
#pragma unroll
        for (int i = 0; i < 4; ++i) {
            float s = ss[i];
            s += __shfl_xor(s, 1); s += __shfl_xor(s, 2); s += __shfl_xor(s, 4);
            if ((tid & 7) == 0) sRs[(tid >> 3) + 32 * i] = rsqrtf(s * (1.0f / 1024.0f) + EPS);
        }
        __syncthreads();
    }
    epi(acc, tm, tn, wr, wc, fr, fq, sRs);
}

__device__ __forceinline__ bool gemm_ticket(unsigned* ctr, int nt, int& tm, int& tn, char* smem) {
    int* sT = (int*)(smem + 32768 + 512);
    const int xcd = get_bid() & 7;
    if (get_tid() == 0) sT[0] = (int)atomicAdd(ctr + xcd * 32, 1u);
    __syncthreads();
    const int j = sT[0];
    if (j >= 32 * nt) return false;
    const int full = nt >> 3, rem = nt & 7;
    int tn_g, tm_g, q;
    if (j < full * 256) { tn_g = j >> 8; const int r = j & 255; tm_g = r >> 6; q = r & 63; }
    else { const int r = j - full * 256; tn_g = full; tm_g = r / (8 * rem); q = r % (8 * rem); }
    tm = ((tm_g * 8 + (q & 7)) * 8) + xcd; tn = tn_g * 8 + (q >> 3); return true;
}


template <class Epi>
__device__ __forceinline__ void gemm_tile64(const bf16_t* A, const bf16_t* Bt, int tm, int tn, const Epi& epi, char* smem, const float* ssq, int nparts) {
    constexpr int K = 1024;
    bf16_t* sA = (bf16_t*)smem;
    bf16_t* sB = sA + 8192;
    float* sRs = (float*)(smem + 32768);
    const int tid = get_tid(), lane = tid & 63, wid = tid >> 6, wr = wid >> 1, wc = wid & 1, fr = lane & 15, fq = lane >> 4;
    f32x4 acc[4][4];
#pragma unroll
    for (int m = 0; m < 4; ++m)
#pragma unroll
        for (int n = 0; n < 4; ++n) acc[m][n] = (f32x4){0.f, 0.f, 0.f, 0.f};
    if (nparts > 0 && tid < 128) {
        float sq = 0.f;
        for (int q = 0; q < nparts; ++q) sq += ssq[(size_t)q * T + (size_t)tm * 128 + tid];
        sRs[tid] = rsqrtf(sq * (1.0f / 1024.0f) + EPS);
    }
    const int lrow = tid >> 3, lc8 = tid & 7;
    const bf16_t* Ap = A + ((size_t)tm * 128 + lrow) * K + lc8 * 8;
    const bf16_t* Bp = Bt + ((size_t)tn * 128 + lrow) * K + lc8 * 8;
    struct Slab { u32x4 a[4], b[4]; };
    auto gload = [&](int kt, Slab& sl) {
#pragma unroll
        for (int i = 0; i < 4; ++i) { sl.a[i] = *(const u32x4*)(Ap + (size_t)(32 * i) * K + kt * 64); sl.b[i] = *(const u32x4*)(Bp + (size_t)(32 * i) * K + kt * 64); }
    };
    auto sstore = [&](const Slab& sl) {
#pragma unroll
        for (int i = 0; i < 4; ++i) {
            const int r = lrow + 32 * i;
            *(u32x4*)(sA + r * 64 + ((lc8 ^ ((r >> 1) & 7)) * 8)) = sl.a[i];
            const int rs = (r & 64) | (((r >> 2) & 3) << 4) | (((r >> 4) & 3) << 2) | (r & 3);
            *(u32x4*)(sB + rs * 64 + ((lc8 ^ ((rs >> 1) & 7)) * 8)) = sl.b[i];
        }
    };
    auto compute = [&]() {
#pragma unroll
        for (int ks = 0; ks < 2; ++ks) {
            bf16x8 af[4], bfr[4];
#pragma unroll
            for (int m = 0; m < 4; ++m) { const int r = wr * 64 + m * 16 + fr; af[m] = *(const bf16x8*)(sA + r * 64 + (((ks * 4 + fq) ^ ((r >> 1) & 7)) * 8)); }
#pragma unroll
            for (int n = 0; n < 4; ++n) { const int r = wc * 64 + n * 16 + fr; bfr[n] = *(const bf16x8*)(sB + r * 64 + (((ks * 4 + fq) ^ ((r >> 1) & 7)) * 8)); }
#pragma unroll
            for (int m = 0; m < 4; ++m)
#pragma unroll
                for (int n = 0; n < 4; ++n) acc[m][n] = __builtin_amdgcn_mfma_f32_16x16x32_bf16(bfr[n], af[m], acc[m][n], 0, 0, 0);
        }
    };
    Slab s0;
    gload(0, s0);
    for (int kt = 0; kt < 16; ++kt) {
        __syncthreads(); sstore(s0); __syncthreads();
        gload(min(kt + 1, 15), s0);
        compute();
    }
    epi(acc, tm, tn, wr, wc, fr, fq, sRs);
}

__device__ __forceinline__ bool gemm_next(int it, int nt, int& tm, int& tn) {
    const int G8 = gridDim.x >> 3;
    const int xcd = get_bid() & 7, slot = get_bid() >> 3;
    const int j = it * G8 + slot;
    if (j >= 32 * nt) return false;
    const int full = nt >> 3, rem = nt & 7;
    int tn_g, tm_g, q;
    if (j < full * 256) { tn_g = j >> 8; const int r = j & 255; tm_g = r >> 6; q = r & 63; }
    else { const int r = j - full * 256; tn_g = full; tm_g = r / (8 * rem); q = r % (8 * rem); }
    tm = ((tm_g * 8 + (q & 7)) * 8) + xcd; tn = tn_g * 8 + (q >> 3); return true;
}

struct EpiInProj {
    const Params* p; int l;
    __device__ __forceinline__ void operator()(const f32x4 (&acc)[4][4], int tm, int tn, int wr, int wc, int fr, int fq, const float* sRs) const {
        const int col0 = tn * 128 + wc * 64 + fq * 16;
#pragma unroll
        for (int m = 0; m < 4; ++m) {
            const int rl = wr * 64 + m * 16 + fr; const float rs = sRs[rl]; const size_t row = (size_t)tm * 128 + rl;
            const f32x4 v0 = acc[m][0] * rs, v1 = acc[m][1] * rs, v2 = acc[m][2] * rs, v3 = acc[m][3] * rs;
            if (col0 == F0) {
                const float* bf = p->b_forget + l * 8;
                f32x4 o0, o1;
#pragma unroll
                for (int j = 0; j < 4; ++j) {
                    const float z0 = v0[j] + bf[j], z1 = v1[j] + bf[4 + j];
                    o0[j] = fminf(z0, 0.f) - log1p_pos(__expf(-fabsf(z0))); o1[j] = fminf(z1, 0.f) - log1p_pos(__expf(-fabsf(z1)));
                }
                *(f32x4*)(p->logf + row * 8) = o0; *(f32x4*)(p->logf + row * 8 + 4) = o1;
            }
            if (col0 + 8 <= NIN) { u32x4 w; w.x = pk_bf16(v0[0], v0[1]); w.y = pk_bf16(v0[2], v0[3]); w.z = pk_bf16(v1[0], v1[1]); w.w = pk_bf16(v1[2], v1[3]); *(u32x4*)(p->proj + row * NIN + col0) = w; }
            if (col0 + 16 <= NIN) { u32x4 w; w.x = pk_bf16(v2[0], v2[1]); w.y = pk_bf16(v2[2], v2[3]); w.z = pk_bf16(v3[0], v3[1]); w.w = pk_bf16(v3[2], v3[3]); *(u32x4*)(p->proj + row * NIN + col0 + 8) = w; }
        }
    }
};

struct EpiOutProj {
    const float* xin; float* xout; bf16_t* xb; float* ssq;
    __device__ __forceinline__ void operator()(const f32x4 (&acc)[4][4], int tm, int tn, int wr, int wc, int fr, int fq, const float*) const {
        const int col0 = tn * 128 + wc * 64 + fq * 16;
#pragma unroll
        for (int m = 0; m < 4; ++m) {
            const size_t row = (size_t)tm * 128 + wr * 64 + m * 16 + fr;
            f32x4 o[4]; float sq = 0.f;
#pragma unroll
            for (int n = 0; n < 4; ++n) {
                o[n] = *(const f32x4*)(xin + row * 1024 + col0 + n * 4) + acc[m][n];
                *(f32x4*)(xout + row * 1024 + col0 + n * 4) = o[n];
                sq += o[n][0] * o[n][0] + o[n][1] * o[n][1] + o[n][2] * o[n][2] + o[n][3] * o[n][3];
            }
            u32x4 w0, w1;
            w0.x = pk_bf16(o[0][0], o[0][1]); w0.y = pk_bf16(o[0][2], o[0][3]); w0.z = pk_bf16(o[1][0], o[1][1]); w0.w = pk_bf16(o[1][2], o[1][3]);
            w1.x = pk_bf16(o[2][0], o[2][1]); w1.y = pk_bf16(o[2][2], o[2][3]); w1.z = pk_bf16(o[3][0], o[3][1]); w1.w = pk_bf16(o[3][2], o[3][3]);
            *(u32x4*)(xb + row * 1024 + col0) = w0; *(u32x4*)(xb + row * 1024 + col0 + 8) = w1;
            sq += __shfl_xor(sq, 16); sq += __shfl_xor(sq, 32);
            if (fq == 0) ssq[(size_t)(tn * 2 + wc) * T + row] = sq;
        }
    }
};

struct EpiScores {
    float* scT; float* rstd2;
    __device__ __forceinline__ void operator()(const f32x4 (&acc)[4][4], int tm, int tn, int wr, int wc, int fr, int fq, const float* sRs) const {
#pragma unroll
        for (int m = 0; m < 4; ++m) {
            const int rl = wr * 64 + m * 16 + fr;
            const float rs = sRs[rl];
            if (tn == 0 && wc == 0 && fq == 0) rstd2[(size_t)tm * 128 + rl] = rs;
#pragma unroll
            for (int n = 0; n < 4; ++n) {
                const int col = tn * 128 + wc * 64 + fq * 16 + n * 4;
                __builtin_nontemporal_store(acc[m][n] * rs, (f32x4*)(scT + (((size_t)(tm * 2 + (rl >> 6)) * 512 + (col >> 2)) * 64 + (rl & 63)) * 4));
            }
        }
    }
};

__device__ void cumsum_item(const Params& p, int bh, char* smem) {
    float* sm = (float*)smem;
    const int b = bh >> 3, h = bh & 7, tid = get_tid(), lane = tid & 63, wid = tid >> 6;
    const float* src = p.logf + ((size_t)b * S + tid * 32) * 8 + h;
    float loc[32]; float run = 0.f;
#pragma unroll
    for (int i = 0; i < 32; ++i) { run += src[i * 8]; loc[i] = run; }
    float incl = run;
#pragma unroll
    for (int o = 1; o < 64; o <<= 1) { const float t = __shfl_up(incl, o); if (lane >= o) incl += t; }
    if (lane == 63) sm[wid] = incl;
    __syncthreads();
    float wbase = 0.f;
    for (int w = 0; w < wid; ++w) wbase += sm[w];
    const float excl = wbase + incl - run;
    float* dst = p.kb + (size_t)bh * S + tid * 32;
#pragma unroll
    for (int i = 0; i < 32; i += 4) {
        float4 o; o.x = -(excl + loc[i]) * LOG2E; o.y = -(excl + loc[i + 1]) * LOG2E; o.z = -(excl + loc[i + 2]) * LOG2E; o.w = -(excl + loc[i + 3]) * LOG2E;
        *(float4*)(dst + i) = o;
    }
    __syncthreads();
}

__device__ void conv_item(const Params& p, int l, int item, char* smem) {
    bf16_t* sG = (bf16_t*)smem;
    float* sY = (float*)(smem + 46 * 256 * 2);
    const int b = item >> 9, tt = item & 511, t0 = tt * 16, tid = get_tid(), lane = tid & 63, wid = tid >> 6;
    const bf16_t* projb = p.proj + (size_t)b * S * NIN;
#pragma unroll
    for (int i = 0; i < 6; ++i) {
        const int task = tid + 256 * i, r = task >> 5, cc = task & 31;
        if (r < 46) {
            const int t = t0 - 30 + r;
            uint4 w = {0u, 0u, 0u, 0u};
            if (t >= 0) {
                const uint4 a = *(const uint4*)(projb + (size_t)t * NIN + C0 + cc * 8);
                const uint4 g = *(const uint4*)(projb + (size_t)t * NIN + C0 + 256 + cc * 8);
                w.x = pk_bf16(bflo(a.x) * sigmoidf_(bflo(g.x)), bfhi(a.x) * sigmoidf_(bfhi(g.x)));
                w.y = pk_bf16(bflo(a.y) * sigmoidf_(bflo(g.y)), bfhi(a.y) * sigmoidf_(bfhi(g.y)));
                w.z = pk_bf16(bflo(a.z) * sigmoidf_(bflo(g.z)), bfhi(a.z) * sigmoidf_(bfhi(g.z)));
                w.w = pk_bf16(bflo(a.w) * sigmoidf_(bflo(g.w)), bfhi(a.w) * sigmoidf_(bfhi(g.w)));
            }
            *(uint4*)(sG + r * 256 + cc * 8) = w;
        }
    }
    float wk[31];
#pragma unroll
    for (int k = 0; k < 31; ++k) wk[k] = p.conv_w[((size_t)l * 31 + k) * 256 + tid];
    const float bias = p.conv_b[l * 256 + tid];
    __syncthreads();
#pragma unroll 1
    for (int tl = 0; tl < 16; ++tl) {
        float y = bias;
#pragma unroll
        for (int k = 0; k < 31; ++k) y += wk[k] * bf2f(sG[(tl + k) * 256 + tid]);
        sY[tl * 256 + tid] = y;
    }
    __syncthreads();
    const float4 g4 = *(const float4*)(p.ln_g + l * 256 + lane * 4), b4 = *(const float4*)(p.ln_b + l * 256 + lane * 4);
#pragma unroll
    for (int j = 0; j < 4; ++j) {
        const int tl = wid * 4 + j;
        const float4 y = *(const float4*)(sY + tl * 256 + lane * 4);
        const float s1 = wave_sum(y.x + y.y + y.z + y.w);
        const float mean = s1 * (1.0f / 256.0f);
        const float dx = y.x - mean, dy = y.y - mean, dz = y.z - mean, dw = y.w - mean;
        const float s2 = wave_sum(dx * dx + dy * dy + dz * dz + dw * dw);
        const float rstd = rsqrtf(s2 * (1.0f / 256.0f) + EPS);
        float o0 = dx * rstd * g4.x + b4.x, o1 = dy * rstd * g4.y + b4.y, o2 = dz * rstd * g4.z + b4.z, o3 = dw * rstd * g4.w + b4.w;
        o0 *= sigmoidf_(o0); o1 *= sigmoidf_(o1); o2 *= sigmoidf_(o2); o3 *= sigmoidf_(o3);
        uint2 w; w.x = pk_bf16(o0, o1); w.y = pk_bf16(o2, o3);
        *(uint2*)(p.mixed + ((size_t)b * S + t0 + tl) * 1024 + 512 + lane * 4) = w;
    }
    __syncthreads();
}

__device__ void rnn1_item(const Params& p, int l, int item, char* smem) {
    float* sX = (float*)smem;
    float* sWr = sX + 67 * 64;
    float* sWi = sWr + 4096;
    float* sAg = sWi + 4096;
    const int hb = item & 3, j = (item >> 2) & 127, b = item >> 9, t0 = j * 64;
    const int tid = get_tid(), c = tid & 63, q = tid >> 6;
    const bf16_t* projb = p.proj + (size_t)b * S * NIN;
#pragma unroll
    for (int i = 0; i < 3; ++i) {
        const int r = (tid >> 3) + 32 * i, c8 = tid & 7;
        if (r < 67) {
            const int t = t0 - 3 + r;
            uint4 a = {0u, 0u, 0u, 0u};
            if (t >= 0) a = *(const uint4*)(projb + (size_t)t * NIN + R0 + hb * 64 + c8 * 8);
            float* d = sX + r * 64 + c8 * 8;
            d[0] = bflo(a.x); d[1] = bfhi(a.x); d[2] = bflo(a.y); d[3] = bfhi(a.y); d[4] = bflo(a.z); d[5] = bfhi(a.z); d[6] = bflo(a.w); d[7] = bfhi(a.w);
        }
    }
    {
        const float* wr = p.rg_w_r + ((size_t)l * 4 + hb) * 4096; const float* wi = p.rg_w_i + ((size_t)l * 4 + hb) * 4096;
#pragma unroll
        for (int i = 0; i < 16; ++i) { sWr[tid + 256 * i] = wr[tid + 256 * i]; sWi[tid + 256 * i] = wi[tid + 256 * i]; }
    }
    const int ch = hb * 64 + c;
    float cw[4];
#pragma unroll
    for (int k = 0; k < 4; ++k) cw[k] = p.rg_conv_w[((size_t)l * 4 + k) * 256 + ch];
    const float cb = p.rg_conv_b[l * 256 + ch];
    __syncthreads();
    float xc[16];
#pragma unroll
    for (int i = 0; i < 16; ++i) {
        const int tl = q * 16 + i;
        xc[i] = cb + cw[0] * sX[(tl + 0) * 64 + c] + cw[1] * sX[(tl + 1) * 64 + c] + cw[2] * sX[(tl + 2) * 64 + c] + cw[3] * sX[(tl + 3) * 64 + c];
    }
    __syncthreads();
#pragma unroll
    for (int i = 0; i < 16; ++i) sX[(q * 16 + i) * 64 + c] = xc[i];
    __syncthreads();
    float ar[16], ai[16];
#pragma unroll
    for (int i = 0; i < 16; ++i) { ar[i] = 0.f; ai[i] = 0.f; }
    for (int k = 0; k < 64; ++k) {
        const float wrv = sWr[k * 64 + c], wiv = sWi[k * 64 + c];
#pragma unroll
        for (int i = 0; i < 16; ++i) { const float xv = sX[(q * 16 + i) * 64 + k]; ar[i] += xv * wrv; ai[i] += xv * wiv; }
    }
    const float br = p.rg_b_r[l * 256 + ch], bi = p.rg_b_i[l * 256 + ch];
    const float lam = p.rg_lambda[l * 256 + ch];
    const float sp = log1p_pos(__expf(-lam));
    float hl[16], Pl[16];
    float hrun = 0.f, prun = 1.f;
#pragma unroll
    for (int i = 0; i < 16; ++i) {
        const float r = sigmoidf_(ar[i] + br), ig = sigmoidf_(ai[i] + bi);
        const float log_a = -8.0f * r * sp;
        const float a = __expf(log_a);
        const float mult = sqrtf(neg_expm1_neg(2.0f * log_a));
        const float bt = mult * ig * xc[i];
        hrun = a * hrun + bt; prun *= a;
        hl[i] = hrun; Pl[i] = prun;
    }
    sAg[q * 64 + c] = prun; sAg[256 + q * 64 + c] = hrun;
    __syncthreads();
    float carry = 0.f, pprev = 1.f;
    for (int qq = 0; qq < q; ++qq) { const float pe = sAg[qq * 64 + c], he = sAg[256 + qq * 64 + c]; carry = pe * carry + he; pprev *= pe; }
    unsigned* sHP = (unsigned*)sWr;
#pragma unroll
    for (int i = 0; i < 16; ++i) sHP[(q * 16 + i) * 64 + c] = pk_bf16(hl[i] + Pl[i] * carry, Pl[i] * pprev);
    if (q == 3) {
        const size_t o = ((size_t)b * 128 + j) * 256 + ch;
        *(f32x2*)(p.AB + 2 * o) = (f32x2){Pl[15] * pprev, hl[15] + Pl[15] * carry};
    }
    __syncthreads();
#pragma unroll
    for (int i = 0; i < 4; ++i) {
        const int tl = (tid >> 4) + 16 * i, c4 = (tid & 15) * 4;
        *(u32x4*)(p.HP + ((size_t)b * S + t0 + tl) * 256 + hb * 64 + c4) = *(const u32x4*)(sHP + tl * 64 + c4);
    }
    __syncthreads();
}

constexpr int ATT_BUF = 18688;
__device__ void attn_item(const Params& p, int s_idx, char* smem) {
    const int qb = 63 - (s_idx >> 5), bh = s_idx & 31, b = bh >> 3, h = bh & 7;
    const int tid = get_tid(), lane = tid & 63, wid = tid >> 6, ql = lane & 31, hh = lane >> 5;
    const int qrow = qb * 128 + wid * 32 + ql;
    const bf16_t* projb = p.proj + (size_t)b * S * NIN;
    bf16x8 qf[4];
#pragma unroll
    for (int kk = 0; kk < 4; ++kk) qf[kk] = *(const bf16x8*)(projb + (size_t)qrow * NIN + h * 64 + kk * 16 + hh * 8);
    f32x16 O0, O1;
#pragma unroll
    for (int i = 0; i < 16; ++i) { O0[i] = 0.f; O1[i] = 0.f; }
    float mrun = -INFINITY, lsum = 0.f;
    const int nkt = qb * 2 + 2;
    const int wave_last = (qb * 128 + wid * 32 + 31) >> 6;
    const int wave_q0 = qb * 128 + wid * 32;
    const float sc = 0.125f * LOG2E;
    struct KV { u32x4 rk[2], rv[2]; float rkb; };
    KV sa;
    auto gload = [&](int kt, KV& st) {
#pragma unroll
        for (int i = 0; i < 2; ++i) {
            const int c = tid + 256 * i, key = c >> 3, dc = c & 7;
            const bf16_t* src = projb + (size_t)(kt * 64 + key) * NIN + h * 64 + dc * 8;
            st.rk[i] = *(const u32x4*)(src + 512);
            const int keyv = c & 63, dcv = c >> 6;
            st.rv[i] = *(const u32x4*)(projb + (size_t)(kt * 64 + keyv) * NIN + 1024 + h * 64 + dcv * 8);
        }
        st.rkb = p.kb[(size_t)bh * S + kt * 64 + (tid & 63)];
    };
    auto sstore = [&](int buf, const KV& st) {
        bf16_t* sK = (bf16_t*)(smem + buf * ATT_BUF); bf16_t* sVt = sK + 64 * 72; float* sKb = (float*)(smem + buf * ATT_BUF + 18432);
#pragma unroll
        for (int i = 0; i < 2; ++i) {
            const int c = tid + 256 * i, key = c >> 3, dc = c & 7;
            *(u32x4*)(sK + key * 72 + dc * 8) = st.rk[i];
            const unsigned w0 = st.rv[i].x, w1 = st.rv[i].y, w2 = st.rv[i].z, w3 = st.rv[i].w;
            bf16_t* d = sVt + ((c >> 6) * 8) * 72 + (c & 63);
            d[0 * 72] = (bf16_t)(w0 & 0xffffu); d[1 * 72] = (bf16_t)(w0 >> 16);
            d[2 * 72] = (bf16_t)(w1 & 0xffffu); d[3 * 72] = (bf16_t)(w1 >> 16);
            d[4 * 72] = (bf16_t)(w2 & 0xffffu); d[5 * 72] = (bf16_t)(w2 >> 16);
            d[6 * 72] = (bf16_t)(w3 & 0xffffu); d[7 * 72] = (bf16_t)(w3 >> 16);
        }
        if (tid < 64) sKb[tid] = st.rkb;
    };
    const int pr = (ql & 0x13) | ((ql & 4) << 1) | ((ql & 8) >> 1);
    auto compute = [&](int kt, int buf) {
        if (kt <= wave_last) {
            const bf16_t* sK = (const bf16_t*)(smem + buf * ATT_BUF); const bf16_t* sVt = sK + 64 * 72; const float* sKb = (const float*)(smem + buf * ATT_BUF + 18432);
            f32x16 S0, S1;
#pragma unroll
            for (int i = 0; i < 16; ++i) { S0[i] = 0.f; S1[i] = 0.f; }
#pragma unroll
            for (int kk = 0; kk < 4; ++kk) {
                const bf16x8 k0 = *(const bf16x8*)(sK + pr * 72 + kk * 16 + hh * 8);
                const bf16x8 k1 = *(const bf16x8*)(sK + (32 + pr) * 72 + kk * 16 + hh * 8);
                S0 = __builtin_amdgcn_mfma_f32_32x32x16_bf16(k0, qf[kk], S0, 0, 0, 0);
                S1 = __builtin_amdgcn_mfma_f32_32x32x16_bf16(k1, qf[kk], S1, 0, 0, 0);
            }
            float sv[32];
#pragma unroll
            for (int g = 0; g < 4; ++g) {
                const int kbase = (g >> 1) * 32 + (g & 1) * 16 + 8 * hh;
                const float4 b0 = *(const float4*)(sKb + kbase), b1 = *(const float4*)(sKb + kbase + 4);
                const int o = (g & 1) * 8;
                if (g >> 1) {
                    sv[g * 8 + 0] = S1[o + 0] * sc + b0.x; sv[g * 8 + 1] = S1[o + 1] * sc + b0.y; sv[g * 8 + 2] = S1[o + 2] * sc + b0.z; sv[g * 8 + 3] = S1[o + 3] * sc + b0.w;
                    sv[g * 8 + 4] = S1[o + 4] * sc + b1.x; sv[g * 8 + 5] = S1[o + 5] * sc + b1.y; sv[g * 8 + 6] = S1[o + 6] * sc + b1.z; sv[g * 8 + 7] = S1[o + 7] * sc + b1.w;
                } else {
                    sv[g * 8 + 0] = S0[o + 0] * sc + b0.x; sv[g * 8 + 1] = S0[o + 1] * sc + b0.y; sv[g * 8 + 2] = S0[o + 2] * sc + b0.z; sv[g * 8 + 3] = S0[o + 3] * sc + b0.w;
                    sv[g * 8 + 4] = S0[o + 4] * sc + b1.x; sv[g * 8 + 5] = S0[o + 5] * sc + b1.y; sv[g * 8 + 6] = S0[o + 6] * sc + b1.z; sv[g * 8 + 7] = S0[o + 7] * sc + b1.w;
                }
            }
            if (kt * 64 + 63 > wave_q0) {
#pragma unroll
                for (int g = 0; g < 4; ++g) {
                    const int kbase = kt * 64 + (g >> 1) * 32 + (g & 1) * 16 + 8 * hh;
#pragma unroll
                    for (int e = 0; e < 8; ++e) if (kbase + e > qrow) sv[g * 8 + e] = -INFINITY;
                }
            }
            float mx = sv[0];
#pragma unroll
            for (int i = 1; i < 32; ++i) mx = fmaxf(mx, sv[i]);
            mx = fmaxf(mx, __shfl_xor(mx, 32));
            const float mnew = fmaxf(mrun, mx);
            const float alpha = __builtin_amdgcn_exp2f(mrun - mnew);
            mrun = mnew;
            float psum = 0.f;
#pragma unroll
            for (int i = 0; i < 32; ++i) { sv[i] = __builtin_amdgcn_exp2f(sv[i] - mnew); psum += sv[i]; }
            lsum = lsum * alpha + psum;
#pragma unroll
            for (int i = 0; i < 16; ++i) { O0[i] *= alpha; O1[i] *= alpha; }
#pragma unroll
            for (int g = 0; g < 4; ++g) {
                bf16x8 pf;
                {
                    const unsigned u0 = pk_bf16(sv[g * 8 + 0], sv[g * 8 + 1]), u1 = pk_bf16(sv[g * 8 + 2], sv[g * 8 + 3]);
                    const unsigned u2 = pk_bf16(sv[g * 8 + 4], sv[g * 8 + 5]), u3 = pk_bf16(sv[g * 8 + 6], sv[g * 8 + 7]);
                    const uint4 uu = {u0, u1, u2, u3};
                    pf = __builtin_bit_cast(bf16x8, uu);
                }
                const int koff = (g >> 1) * 32 + (g & 1) * 16 + 8 * hh;
                const bf16x8 v0 = *(const bf16x8*)(sVt + ql * 72 + koff);
                const bf16x8 v1 = *(const bf16x8*)(sVt + (32 + ql) * 72 + koff);
                O0 = __builtin_amdgcn_mfma_f32_32x32x16_bf16(v0, pf, O0, 0, 0, 0);
                O1 = __builtin_amdgcn_mfma_f32_32x32x16_bf16(v1, pf, O1, 0, 0, 0);
            }
        }
    };
    gload(0, sa); sstore(0, sa); __syncthreads();
    for (int kt = 0; kt < nkt; kt += 2) {
        gload(kt + 1, sa);
        compute(kt, 0);
        sstore(1, sa);
        __syncthreads();
        gload(min(kt + 2, nkt - 1), sa);
        compute(kt + 1, 1);
        if (kt + 2 < nkt) sstore(0, sa);
        __syncthreads();
    }
    const float ltot = lsum + __shfl_xor(lsum, 32);
    const float inv = 1.0f / ltot;
    bf16_t* orow = p.mixed + ((size_t)b * S + qrow) * 1024 + h * 64;
#pragma unroll
    for (int g = 0; g < 4; ++g) {
        uint2 w0, w1;
        w0.x = pk_bf16(O0[g * 4 + 0] * inv, O0[g * 4 + 1] * inv); w0.y = pk_bf16(O0[g * 4 + 2] * inv, O0[g * 4 + 3] * inv);
        w1.x = pk_bf16(O1[g * 4 + 0] * inv, O1[g * 4 + 1] * inv); w1.y = pk_bf16(O1[g * 4 + 2] * inv, O1[g * 4 + 3] * inv);
        *(uint2*)(orow + 8 * g + 4 * hh) = w0;
        *(uint2*)(orow + 32 + 8 * g + 4 * hh) = w1;
    }
}

__device__ void rnn2_item(const Params& p, int item, char* smem) {
    float* sCarry = (float*)smem;
    float* sSeg = sCarry + 64;
    const int hb = item & 3, j = (item >> 2) & 127, b = item >> 9, t0 = j * 64;
    const int tid = get_tid();
    {
        const int w = tid >> 6, c = tid & 63, j0 = (j * w) >> 2, j1 = (j * (w + 1)) >> 2;
        float a = 1.f, bb = 0.f;
        const f32x2* ab = (const f32x2*)p.AB + ((size_t)b * 128) * 256 + hb * 64 + c;
#pragma unroll 16
        for (int jp = j0; jp < j1; ++jp) { const f32x2 v = ab[(size_t)jp * 256]; bb = v.x * bb + v.y; a *= v.x; }
        sSeg[(w * 2 + 0) * 64 + c] = a; sSeg[(w * 2 + 1) * 64 + c] = bb;
    }
    __syncthreads();
    if (tid < 64) {
        float carry = sSeg[1 * 64 + tid];
#pragma unroll
        for (int w = 1; w < 4; ++w) carry = sSeg[(w * 2) * 64 + tid] * carry + sSeg[(w * 2 + 1) * 64 + tid];
        sCarry[tid] = carry;
    }
    __syncthreads();
    const int cc = tid & 7;
    const f32x4 ca = *(const f32x4*)(sCarry + cc * 8), cb = *(const f32x4*)(sCarry + cc * 8 + 4);
    const float cr[8] = {ca[0], ca[1], ca[2], ca[3], cb[0], cb[1], cb[2], cb[3]};
#pragma unroll
    for (int i = 0; i < 2; ++i) {
        const size_t t = (size_t)b * S + t0 + (tid >> 3) + 32 * i;
        const u32x4 h0 = *(const u32x4*)(p.HP + t * 256 + hb * 64 + cc * 8), h1 = *(const u32x4*)(p.HP + t * 256 + hb * 64 + cc * 8 + 4);
        const u32x4 gt = *(const u32x4*)(p.proj + t * NIN + G0 + hb * 64 + cc * 8);
        const unsigned hp[8] = {h0.x, h0.y, h0.z, h0.w, h1.x, h1.y, h1.z, h1.w};
        const unsigned gw[4] = {gt.x, gt.y, gt.z, gt.w};
        float o[8];
#pragma unroll
        for (int e = 0; e < 8; ++e) {
            const float hfull = bflo(hp[e]) + bfhi(hp[e]) * cr[e];
            const float gate = (e & 1) ? bfhi(gw[e >> 1]) : bflo(gw[e >> 1]);
            o[e] = hfull * gelu_tanh(gate);
        }
        u32x4 w; w.x = pk_bf16(o[0], o[1]); w.y = pk_bf16(o[2], o[3]); w.z = pk_bf16(o[4], o[5]); w.w = pk_bf16(o[6], o[7]);
        *(u32x4*)(p.mixed + t * 1024 + 768 + hb * 64 + cc * 8) = w;
    }
    __syncthreads();
}

__device__ __forceinline__ unsigned f2sort(float f) { const unsigned u = __float_as_uint(f); return (u & 0x80000000u) ? ~u : (u | 0x80000000u); }
__device__ __forceinline__ float sort2f(unsigned k) { const unsigned u = (k & 0x80000000u) ? (k & 0x7fffffffu) : ~k; return __uint_as_float(u); }

__device__ __forceinline__ void sort16_desc(unsigned (&v)[16]) {
#pragma unroll
    for (int k = 2; k <= 16; k <<= 1)
#pragma unroll
        for (int j = k >> 1; j > 0; j >>= 1)
#pragma unroll
            for (int i = 0; i < 16; ++i) {
                const int l = i ^ j;
                if (l > i) {
                    const unsigned a = v[i], b = v[l];
                    const bool desc = ((i & k) == 0) || (k == 16);
                    v[i] = desc ? max(a, b) : min(a, b);
                    v[l] = desc ? min(a, b) : max(a, b);
                }
            }
}
__device__ __forceinline__ void merge16_desc(unsigned (&top)[16], const unsigned (&c)[16]) {
#pragma unroll
    for (int i = 0; i < 16; ++i) top[i] = max(top[i], c[15 - i]);
#pragma unroll
    for (int j = 8; j > 0; j >>= 1)
#pragma unroll
        for (int i = 0; i < 16; ++i) {
            const int l = i ^ j;
            if (l > i) { const unsigned a = top[i], b = top[l]; top[i] = max(a, b); top[l] = min(a, b); }
        }
}

__device__ void topk_item(const Params& p, int wi, char* smem) {
    const int tid = get_tid(), lane = tid & 63, wid = tid >> 6;
    int* sIdx = (int*)smem + wid * 2048;
    const int head = wi & 7, tg = wi >> 3, t = tg * 64 + lane;
    float vals[2][16];
    {
        const f32x4* base = (const f32x4*)p.scT + ((size_t)tg * 512 + head * 64) * 64 + lane;
        f32x4 bufA[8], bufB[8];
        auto ldc = [&](int ch, f32x4 (&buf)[8]) {
#pragma unroll
            for (int q = 0; q < 8; ++q) buf[q] = __builtin_nontemporal_load(base + (ch * 8 + q) * 64);
        };
        unsigned top[16];
        auto ins = [&](int ch, const f32x4 (&buf)[8]) {
#pragma unroll
            for (int grp = 0; grp < 2; ++grp) {
                unsigned c[16];
#pragma unroll
                for (int q = 0; q < 4; ++q)
#pragma unroll
                    for (int e = 0; e < 4; ++e)
                        c[q * 4 + e] = (f2sort(buf[grp * 4 + q][e]) & ~127u) | (unsigned)(127 - ((ch & 3) * 32 + (grp * 4 + q) * 4 + e));
                sort16_desc(c);
                if ((ch & 3) == 0 && grp == 0) {
#pragma unroll
                    for (int i = 0; i < 16; ++i) top[i] = c[i];
                } else merge16_desc(top, c);
            }
        };
        auto fin = [&](int half) {
#pragma unroll
            for (int i = 0; i < 16; ++i) { vals[half][i] = sort2f(top[i] & ~127u); sIdx[(half * 16 + i) * 64 + lane] = 127 - (int)(top[i] & 127u); }
        };
        ldc(0, bufA); ldc(1, bufB);
        ins(0, bufA); ldc(2, bufA);
        ins(1, bufB); ldc(3, bufB);
        ins(2, bufA); ldc(4, bufA);
        ins(3, bufB); fin(0); ldc(5, bufB);
        ins(4, bufA); ldc(6, bufA);
        ins(5, bufB); ldc(7, bufB);
        ins(6, bufA);
        ins(7, bufB); fin(1);
    }
    unsigned top[16];
#pragma unroll
    for (int i = 0; i < 16; ++i) top[i] = 0u;
#pragma unroll
    for (int i = 0; i < 16; ++i)
#pragma unroll
        for (int j = 0; j < 16; ++j)
            if ((i + 1) * (j + 1) <= 16) {
                unsigned x = (f2sort(vals[0][i] + vals[1][j]) & ~255u) | (unsigned)(255 - (i * 16 + j));
#pragma unroll
                for (int q = 0; q < 16; ++q) { const unsigned hi = max(top[q], x); x = min(top[q], x); top[q] = hi; }
            }
    float g[16]; float gs = 0.f;
    const float mx = sort2f(top[0] & ~255u);
    int ex[16];
#pragma unroll
    for (int i = 0; i < 16; ++i) {
        g[i] = __expf(sort2f(top[i] & ~255u) - mx); gs += g[i];
        const int ci = 255 - (int)(top[i] & 255u);
        const int e1 = sIdx[(ci >> 4) * 64 + lane], e2 = sIdx[(16 + (ci & 15)) * 64 + lane];
        ex[i] = e1 * 128 + e2;
    }
    const float ginv = 1.0f / gs;
    int* ed = p.experts + (size_t)t * 128 + head * 16; float* gd = p.gates + (size_t)t * 128 + head * 16;
#pragma unroll
    for (int i = 0; i < 16; i += 4) {
        *(int4*)(ed + i) = make_int4(ex[i], ex[i + 1], ex[i + 2], ex[i + 3]);
        *(float4*)(gd + i) = make_float4(g[i] * ginv, g[i + 1] * ginv, g[i + 2] * ginv, g[i + 3] * ginv);
    }
}


constexpr int PEER_LDS_WAVE = 9472;
__device__ __forceinline__ float wave_max(float v) {
#pragma unroll
    for (int o = 32; o >= 1; o >>= 1) v = fmaxf(v, __shfl_xor(v, o));
    return v;
}
__device__ __forceinline__ void peer_u_phase(const Params& p, int l, int x, int wq, int nwq, int lane, int wid, char* smem) {
    const int g = lane >> 3, c = lane & 7, hl = lane >> 5, l32 = lane & 31;
    const int nb = (T / 8 - wq + nwq - 1) / nwq, ntok = nb * 8;
    int* sIds = (int*)(smem + wid * PEER_LDS_WAVE); unsigned char* sXq = (unsigned char*)(sIds + 1024); float* sSh = (float*)(sXq + 1024); float* sPart = sSh + 8;
    const float* ggp = p.norm2_g + l * 1024 + x * 128 + 4 * l32;
    const unsigned char* Ut = p.U8 + ((size_t)(l * 8 + x) * 16384) * 128;
    struct Meta { i32x4 id[4]; f32x4 xv[4]; float rs; };
    auto tok = [&](int k) { const int kk = k < ntok ? k : 0; return ((kk >> 3) * nwq + wq) * 8 + (kk & 7); };
    auto load_meta = [&](int b, Meta& m) {
#pragma unroll
        for (int jj = 0; jj < 4; ++jj) m.id[jj] = *(const i32x4*)(p.experts + (size_t)tok(b * 8 + 2 * jj + hl) * 128 + 4 * l32);
    };
    auto load_x = [&](int b, Meta& m) {
#pragma unroll
        for (int jj = 0; jj < 4; ++jj) m.xv[jj] = *(const f32x4*)(p.out + (size_t)tok(b * 8 + 2 * jj + hl) * 1024 + x * 128 + 4 * l32);
        m.rs = p.rstd2[tok(b * 8 + (lane & 7))];
    };
    auto store_meta = [&](const Meta& m) {
        const f32x4 gg = *(const f32x4*)ggp;
#pragma unroll
        for (int jj = 0; jj < 4; ++jj) {
            const int j = 2 * jj + hl;
            *(i32x4*)(sIds + j * 128 + 4 * l32) = m.id[jj];
            const float rs = __shfl(m.rs, j);
            const f32x4 h = m.xv[jj] * gg * rs;
            float am = fmaxf(fmaxf(fabsf(h[0]), fabsf(h[1])), fmaxf(fabsf(h[2]), fabsf(h[3])));
#pragma unroll
            for (int o = 16; o >= 1; o >>= 1) am = fmaxf(am, __shfl_xor(am, o));
            const float inv = am > 0.f ? 127.0f / am : 0.0f;
            const int q0 = __float2int_rn(h[0] * inv), q1 = __float2int_rn(h[1] * inv), q2 = __float2int_rn(h[2] * inv), q3 = __float2int_rn(h[3] * inv);
            *(unsigned*)(sXq + j * 128 + 4 * l32) = (unsigned)(q0 & 255) | ((unsigned)(q1 & 255) << 8) | ((unsigned)(q2 & 255) << 16) | ((unsigned)q3 << 24);
            if (l32 == 0) sSh[j] = am * (1.0f / 127.0f);
        }
    };
    auto issue = [&](int u, u32x4 (&rows)[8]) {
        const int* ip = sIds + (u >> 1) * 128 + g * 16 + (u & 1) * 8;
        const int4 a = *(const int4*)ip, b = *(const int4*)(ip + 4);
        const int e[8] = {a.x, a.y, a.z, a.w, b.x, b.y, b.z, b.w};
#pragma unroll
        for (int s = 0; s < 8; ++s) rows[s] = *(const u32x4*)(Ut + (unsigned)(e[s] * 128 + c * 16));
    };
    auto compute = [&](int u, const u32x4 (&rows)[8]) {
        const int j = u >> 1;
        const float sh = sSh[j];
        const u32x4 hq = *(const u32x4*)(sXq + j * 128 + c * 16);
        int part[8];
#pragma unroll
        for (int s = 0; s < 8; ++s) {
            int d = __builtin_amdgcn_sdot4((int)rows[s][0], (int)hq[0], 0, false);
            d = __builtin_amdgcn_sdot4((int)rows[s][1], (int)hq[1], d, false);
            d = __builtin_amdgcn_sdot4((int)rows[s][2], (int)hq[2], d, false);
            part[s] = __builtin_amdgcn_sdot4((int)rows[s][3], (int)hq[3], d, false);
        }
#pragma unroll
        for (int o = 4, n = 8; o >= 1; o >>= 1, n >>= 1) {
            const bool up = (lane & o) != 0;
#pragma unroll
            for (int i = 0; i < n / 2; ++i) {
                int lo = part[i], hi = part[i + n / 2];
                asm volatile("" : "+v"(lo), "+v"(hi));
                const int send = up ? lo : hi, keep = up ? hi : lo;
                part[i] = keep + __shfl_xor(send, o);
            }
        }
        sPart[j * 128 + g * 16 + (u & 1) * 8 + c] = (float)part[0] * sh;
    };
    Meta m; load_meta(0, m); load_x(0, m);
    for (int b = 0; b < nb; ++b) {
        __builtin_amdgcn_wave_barrier();
        store_meta(m);
        __builtin_amdgcn_wave_barrier();
        load_meta(min(b + 1, nb - 1), m);
        u32x4 rA[8], rB[8];
        issue(0, rA);
#pragma unroll
        for (int u = 0; u < 16; u += 2) {
            issue(u + 1, rB);
            compute(u, rA);
            if (u + 2 < 16) issue(u + 2, rA);
            if (u == 8) load_x(min(b + 1, nb - 1), m);
            compute(u + 1, rB);
        }
        __builtin_amdgcn_wave_barrier();
#pragma unroll
        for (int jj = 0; jj < 4; ++jj) {
            const int j = 2 * jj + hl, k = b * 8 + j;
            const f32x4 v = *(const f32x4*)(sPart + j * 128 + 4 * l32);
            if (k < ntok) __builtin_nontemporal_store(v, (f32x4*)(p.part + ((size_t)x * T + tok(k)) * 128 + 4 * l32));
        }
    }
}

__device__ __forceinline__ void peer_w_phase(const Params& p, int l) {
    const int tid = get_tid();
    for (size_t i = ((size_t)get_bid() * NTHREADS + tid) * 4; i < (size_t)T * 128; i += (size_t)gridDim.x * NTHREADS * 4) {
        f32x4 hs = __builtin_nontemporal_load((const f32x4*)(p.part + i));
#pragma unroll
        for (int xx = 1; xx < 8; ++xx) hs += __builtin_nontemporal_load((const f32x4*)(p.part + (size_t)xx * T * 128 + i));
        const int4 e = *(const int4*)(p.experts + i);
        const f32x4 gt = *(const f32x4*)(p.gates + i);
        const float* su = p.su + l * 16384; const float* sv = p.sv + l * 16384;
        f32x4 w;
        w[0] = gt[0] * gelu_tanh(hs[0] * su[e.x]) * sv[e.x]; w[1] = gt[1] * gelu_tanh(hs[1] * su[e.y]) * sv[e.y];
        w[2] = gt[2] * gelu_tanh(hs[2] * su[e.z]) * sv[e.z]; w[3] = gt[3] * gelu_tanh(hs[3] * su[e.w]) * sv[e.w];
        *(f32x4*)(p.wbuf + i) = w;
    }
}

__device__ __forceinline__ void peer_v_phase(const Params& p, int l, int x, int wq, int nwq, int lane, int wid, char* smem) {
    const int g = lane >> 3, c = lane & 7, hl = lane >> 5, l32 = lane & 31;
    const int nb = (T / 8 - wq + nwq - 1) / nwq, ntok = nb * 8;
    int* sIds = (int*)(smem + wid * PEER_LDS_WAVE); unsigned char* sWq = (unsigned char*)(sIds + 1024); float* sSw = (float*)(sWq + 1024); float* sOld = sSw + 8;
    const unsigned char* Vt = p.V8 + ((size_t)(l * 8 + x) * 16384) * 128;
    const int ocol = c * 16 + 4 * (g >> 1);
    struct Meta { i32x4 id[4]; f32x4 wv[4]; };
    auto tok = [&](int k) { const int kk = k < ntok ? k : 0; return ((kk >> 3) * nwq + wq) * 8 + (kk & 7); };
    auto load_meta = [&](int b, Meta& m) {
#pragma unroll
        for (int jj = 0; jj < 4; ++jj) {
            const int t = tok(b * 8 + 2 * jj + hl);
            m.id[jj] = *(const i32x4*)(p.experts + (size_t)t * 128 + 4 * l32);
            m.wv[jj] = *(const f32x4*)(p.wbuf + (size_t)t * 128 + 4 * l32);
        }
    };
    auto store_meta = [&](const Meta& m) {
#pragma unroll
        for (int jj = 0; jj < 4; ++jj) {
            const int j = 2 * jj + hl;
            *(i32x4*)(sIds + j * 128 + 4 * l32) = m.id[jj];
            const f32x4 w = m.wv[jj];
            float am = fmaxf(fmaxf(fabsf(w[0]), fabsf(w[1])), fmaxf(fabsf(w[2]), fabsf(w[3])));
#pragma unroll
            for (int o = 16; o >= 1; o >>= 1) am = fmaxf(am, __shfl_xor(am, o));
            const float inv = am > 0.f ? 127.0f / am : 0.0f;
            const int q0 = __float2int_rn(w[0] * inv), q1 = __float2int_rn(w[1] * inv), q2 = __float2int_rn(w[2] * inv), q3 = __float2int_rn(w[3] * inv);
            *(unsigned*)(sWq + j * 128 + 4 * l32) = (unsigned)(q0 & 255) | ((unsigned)(q1 & 255) << 8) | ((unsigned)(q2 & 255) << 16) | ((unsigned)q3 << 24);
            if (l32 == 0) sSw[j] = am * (1.0f / 127.0f);
        }
    };
    auto issue = [&](int u, u32x4 (&rows)[8]) {
        const int* ip = sIds + (u >> 1) * 128 + g * 16 + (u & 1) * 8;
        const int4 a = *(const int4*)ip, b = *(const int4*)(ip + 4);
        const int e[8] = {a.x, a.y, a.z, a.w, b.x, b.y, b.z, b.w};
#pragma unroll
        for (int s = 0; s < 8; ++s) rows[s] = *(const u32x4*)(Vt + (unsigned)(e[s] * 128 + c * 16));
    };
    int acc[16];
    f32x4 oldv;
    auto compute = [&](int u, const u32x4 (&rows)[8], int kbase) {
        const int j = u >> 1;
        if ((u & 1) == 0) {
#pragma unroll
            for (int i = 0; i < 16; ++i) acc[i] = 0;
            oldv = *(const f32x4*)(p.out + (size_t)tok(kbase + j) * 1024 + x * 128 + ocol);
        }
        const uint2 wq2 = *(const uint2*)(sWq + j * 128 + g * 16 + (u & 1) * 8);
#pragma unroll
        for (int hgrp = 0; hgrp < 2; ++hgrp) {
            const int wq4 = (int)(hgrp ? wq2.y : wq2.x);
#pragma unroll
            for (int q = 0; q < 4; ++q) {
                const unsigned r0 = rows[hgrp * 4 + 0][q], r1 = rows[hgrp * 4 + 1][q], r2 = rows[hgrp * 4 + 2][q], r3 = rows[hgrp * 4 + 3][q];
                const unsigned a = __builtin_amdgcn_perm(r1, r0, 0x05010400u), b = __builtin_amdgcn_perm(r1, r0, 0x07030602u);
                const unsigned cc = __builtin_amdgcn_perm(r3, r2, 0x05010400u), d = __builtin_amdgcn_perm(r3, r2, 0x07030602u);
                const unsigned c0 = __builtin_amdgcn_perm(cc, a, 0x05040100u), c1 = __builtin_amdgcn_perm(cc, a, 0x07060302u);
                const unsigned c2 = __builtin_amdgcn_perm(d, b, 0x05040100u), c3 = __builtin_amdgcn_perm(d, b, 0x07060302u);
                acc[4 * q + 0] = __builtin_amdgcn_sdot4((int)c0, wq4, acc[4 * q + 0], false);
                acc[4 * q + 1] = __builtin_amdgcn_sdot4((int)c1, wq4, acc[4 * q + 1], false);
                acc[4 * q + 2] = __builtin_amdgcn_sdot4((int)c2, wq4, acc[4 * q + 2], false);
                acc[4 * q + 3] = __builtin_amdgcn_sdot4((int)c3, wq4, acc[4 * q + 3], false);
            }
        }
        if (u & 1) {
            int part[16];
#pragma unroll
            for (int i = 0; i < 16; ++i) part[i] = acc[i];
#pragma unroll
            for (int o = 32, n = 16; o >= 16; o >>= 1, n >>= 1) {
                const bool up = (lane & o) != 0;
#pragma unroll
                for (int i = 0; i < n / 2; ++i) {
                    int lo = part[i], hi = part[i + n / 2];
                    asm volatile("" : "+v"(lo), "+v"(hi));
                    const int send = up ? lo : hi, keep = up ? hi : lo;
                    part[i] = keep + __shfl_xor(send, o);
                }
            }
#pragma unroll
            for (int i = 0; i < 4; ++i) part[i] += __shfl_xor(part[i], 8);
            const float sw = sSw[j];
            const int k = kbase + j;
            float sq = 0.f;
            if (k < ntok && (g & 1) == 0) {
                f32x4 o = oldv;
                o[0] += (float)part[0] * sw; o[1] += (float)part[1] * sw; o[2] += (float)part[2] * sw; o[3] += (float)part[3] * sw;
                const size_t oi = (size_t)tok(k) * 1024 + x * 128 + ocol;
                *(f32x4*)(p.out + oi) = o;
                if (l == 0) {
                    uint2 wb; wb.x = pk_bf16(o[0], o[1]); wb.y = pk_bf16(o[2], o[3]);
                    *(uint2*)(p.xb + oi) = wb;
                    sq = o[0] * o[0] + o[1] * o[1] + o[2] * o[2] + o[3] * o[3];
                }
            }
            if (l == 0) {
                sq = wave_sum(sq);
                if (k < ntok && lane == 0) p.ssqA[(size_t)x * T + tok(k)] = sq;
            }
        }
    };
    Meta m; load_meta(0, m);
    for (int b = 0; b < nb; ++b) {
        __builtin_amdgcn_wave_barrier();
        store_meta(m);
        __builtin_amdgcn_wave_barrier();
        load_meta(min(b + 1, nb - 1), m);
        u32x4 rA[8], rB[8];
        issue(0, rA);
#pragma unroll
        for (int u = 0; u < 16; u += 2) {
            issue(u + 1, rB);
            compute(u, rA, b * 8);
            if (u + 2 < 16) issue(u + 2, rA);
            compute(u + 1, rB, b * 8);
        }
    }
}

__device__ __forceinline__ void final_norm_token(const Params& p, int t, int lane) {
    float* xr = p.out + (size_t)t * 1024;
    f32x4 v[4];
#pragma unroll
    for (int i = 0; i < 4; ++i) v[i] = *(const f32x4*)(xr + i * 256 + lane * 4);
    float ss = 0.f;
#pragma unroll
    for (int i = 0; i < 4; ++i) ss += v[i][0] * v[i][0] + v[i][1] * v[i][1] + v[i][2] * v[i][2] + v[i][3] * v[i][3];
    ss = wave_sum(ss);
    const float r = rsqrtf(ss * (1.0f / 1024.0f) + EPS);
#pragma unroll
    for (int i = 0; i < 4; ++i) { const f32x4 gg = *(const f32x4*)(p.final_g + i * 256 + lane * 4); *(f32x4*)(xr + i * 256 + lane * 4) = v[i] * r * gg; }
}


#define XB_TMO      128
#define XB_XCNT(j)  (256  + 64 * (j))
#define XB_XSUB(j)  (1280 + 64 * (j))
#define XB_XGEN(j)  (2304 + 64 * (j))
#define XB_TOP      3328
#define XB_TOPGEN   3392
#define XCD_BAR_WORDS 3456
#define XB_SPIN_CAP (1u << 22)
#define LAS __attribute__((address_space(3)))
__device__ __forceinline__ unsigned xb_ld(unsigned* p)              { return __hip_atomic_load(p, __ATOMIC_RELAXED, __HIP_MEMORY_SCOPE_AGENT); }
__device__ __forceinline__ unsigned xb_add(unsigned* p, unsigned v) { return __hip_atomic_fetch_add(p, v, __ATOMIC_RELAXED, __HIP_MEMORY_SCOPE_AGENT); }
__device__ __forceinline__ unsigned xb_xcc_id() { return (unsigned)__builtin_amdgcn_s_getreg((3 << 11) | 20) & 0xFu; }
#define XB_SPIN(cond, bar) do { unsigned _sp = 0; while (cond) { __builtin_amdgcn_s_sleep(1); \
    if ((++_sp & 255u) == 0u) { if (xb_ld(&(bar)[XB_TMO])) break; if (_sp > XB_SPIN_CAP) { atomicAdd(&(bar)[XB_TMO], 1u); break; } } } } while (0)
struct XcdBarrier { unsigned* bar; unsigned x; volatile LAS unsigned* st; };
__device__ __forceinline__ XcdBarrier xcd_barrier_post(unsigned* bar, volatile LAS unsigned* st) {
    XcdBarrier b; b.bar = bar; b.x = xb_xcc_id(); b.st = st;
    if (threadIdx.x == 0) (void)xb_add(&bar[XB_XCNT(b.x)], 1u);
    return b;
}
__device__ __forceinline__ void xcd_barrier_complete(unsigned* bar, unsigned x, unsigned& nloc, unsigned& nx) {
    const unsigned G = gridDim.x * gridDim.y * gridDim.z;
    unsigned sum, cnt, mine, sp = 0u;
    for (;;) {
        sum = 0u; cnt = 0u; mine = 0u;
#pragma unroll
        for (unsigned j = 0; j < 16; ++j) { const unsigned c = xb_ld(&bar[XB_XCNT(j)]); sum += c; cnt += (c > 0u) ? 1u : 0u; mine = (j == x) ? c : mine; }
        if (sum == G) break;
        __builtin_amdgcn_s_sleep(1);
        if ((++sp & 255u) == 0u) { if (xb_ld(&bar[XB_TMO])) break; if (sp > XB_SPIN_CAP) { atomicAdd(&bar[XB_TMO], 1u); break; } }
    }
    nloc = mine > 0u ? mine : 1u; nx = cnt > 0u ? cnt : 1u;
}
__device__ __forceinline__ void xcd_barrier(const XcdBarrier& b) {
    asm volatile("s_waitcnt vmcnt(0)" ::: "memory");
    __syncthreads();
    if (threadIdx.x == 0) {
        unsigned* bar = b.bar;
        __builtin_amdgcn_s_waitcnt(0);
        unsigned nloc = b.st[0], nx = b.st[1];
        if (nloc == 0u) { xcd_barrier_complete(bar, b.x, nloc, nx); b.st[0] = nloc; b.st[1] = nx; }
        const unsigned old = xb_add(&bar[XB_XSUB(b.x)], 1u);
        const unsigned gen = old / nloc;
        if (old + 1u == (gen + 1u) * nloc) {
            __builtin_amdgcn_fence(__ATOMIC_RELEASE, "agent");
            asm volatile("s_waitcnt vmcnt(0)" ::: "memory");
            const unsigned og = xb_add(&bar[XB_TOP], 1u);
            const unsigned tg = og / nx;
            if (og + 1u == (tg + 1u) * nx) xb_add(&bar[XB_TOPGEN], 1u);
            else XB_SPIN(xb_ld(&bar[XB_TOPGEN]) == tg, bar);
            __builtin_amdgcn_fence(__ATOMIC_ACQUIRE, "agent");
            xb_add(&bar[XB_XGEN(b.x)], 1u);
            asm volatile("s_waitcnt vmcnt(0)" ::: "memory");
        } else {
            XB_SPIN(xb_ld(&bar[XB_XGEN(b.x)]) == gen, bar);
            __builtin_amdgcn_fence(__ATOMIC_ACQUIRE, "agent");
            asm volatile("s_waitcnt vmcnt(0)" ::: "memory");
        }
    }
    __syncthreads();
}

__device__ void run_phase(const Params& p, int ph, char* smem) {
    if (ph == 0) { phase_prep(p, smem); return; }
    if (ph == 19) {
        const int tid = get_tid(), wid = __builtin_amdgcn_readfirstlane(tid >> 6), lane = tid & 63;
        for (int t = get_bid() * 4 + wid; t < T; t += gridDim.x * 4) final_norm_token(p, t, lane);
        return;
    }
    const int l = (ph - 1) / 9, s = (ph - 1) % 9;
    if (s == 0) {
        EpiInProj epi{&p, l};
        int tm, tn;
        while (gemm_ticket(p.ctr + (l * 3 + 0) * 256, 21, tm, tn, smem)) gemm_tile64(p.xb, p.WinT + (size_t)l * NINP * 1024, tm, tn, epi, smem, p.ssqA, l == 0 ? 1 : 8);
    } else if (s == 1) {
        for (int it = get_bid(); it < 32; it += gridDim.x) cumsum_item(p, it, smem);
        for (int it = gridDim.x - 1 - get_bid(); it < 2048; it += gridDim.x) conv_item(p, l, it, smem);
        for (int it = get_bid(); it < 2048; it += gridDim.x) rnn1_item(p, l, it, smem);
    } else if (s == 2) {
        const bool quant_first = ((((unsigned)get_bid() >> 8) ^ (unsigned)get_bid()) & 1u) != 0u;
        const int G = gridDim.x, nr = (2048 + G - 1) / G;
        const int nq = (16384 + G - 1) / G, qper = (nq + nr - 1) / nr;
        auto do_quant = [&](int chunk) {
            const int qt = get_tid();
            for (int i = chunk * qper; i < (chunk + 1) * qper && i < nq; ++i) {
                const int j = i * G + get_bid();
                if (j < 16384) {
                    const int row = (j & 8191) * 4 + (qt >> 6);
                    if (j < 8192) prep_fp8_row(p.pu, p.U8, p.su, row, qt & 63); else prep_fp8_row(p.pv, p.V8, p.sv, row, qt & 63);
                }
            }
        };
        for (int r = 0; r < nr; ++r) {
            if (l == 0 && quant_first) do_quant(r);
            const int pos = (r & 1) ? (G - 1 - get_bid()) : get_bid();
            const int si = r * G + pos;
            if (si < 2048) attn_item(p, si, smem);
            if (l == 0 && !quant_first) do_quant(r);
        }
        for (int it = get_bid(); it < 2048; it += gridDim.x) rnn2_item(p, it, smem);
    } else if (s == 3) {
        EpiOutProj epi{l == 0 ? p.x : (const float*)p.out, p.out, p.xb, p.ssqE};
        int tm, tn;
        while (gemm_ticket(p.ctr + (l * 3 + 1) * 256, 8, tm, tn, smem)) gemm_tile64(p.mixed, p.WoutT + (size_t)l * 1024 * 1024, tm, tn, epi, smem, nullptr, 0);
    } else if (s == 4) {
        EpiScores epi{p.scT, p.rstd2};
        int tm, tn;
        while (gemm_ticket(p.ctr + (l * 3 + 2) * 256, 16, tm, tn, smem)) gemm_tile64(p.xb, p.WcT + (size_t)l * 2048 * 1024, tm, tn, epi, smem, p.ssqE, 16);
    } else if (s == 5) {
        const int wid = get_tid() >> 6;
        for (int it = get_bid(); it < 1024; it += gridDim.x) topk_item(p, it * 4 + wid, smem);
    } else {
        if (s == 7) { peer_w_phase(p, l); return; }
        const int tid = get_tid(), wu = __builtin_amdgcn_readfirstlane(tid >> 6), lane = tid & 63;
        const int x = get_bid() & 7, wq = (get_bid() >> 3) * 4 + wu, nwq = (gridDim.x >> 3) * 4;
        if (s == 6) peer_u_phase(p, l, x, wq, nwq, lane, wu, smem);
        else        peer_v_phase(p, l, x, wq, nwq, lane, wu, smem);
    }
}

__global__ void __launch_bounds__(NTHREADS, 3) mega_kernel(Params p, int ph0, int ph1) {
    __shared__ __attribute__((aligned(16))) char smem[SMEM_BYTES];
    __shared__ __attribute__((aligned(16))) unsigned xb_st[4];
    cg::grid_group grid = cg::this_grid();
    if (threadIdx.x < 4) xb_st[threadIdx.x] = 0u;
    __syncthreads();
    const XcdBarrier xb = xcd_barrier_post(p.bar, (volatile LAS unsigned*)xb_st);
    int ph = ph0, rep = 0;
    while (ph < ph1) {
        run_phase(p, ph, smem);
#ifdef REP_MASK
        const bool again = rep == 0 && ph >= 1 && ph <= 18 && ((REP_MASK >> ((ph - 1) % 9)) & 1);
#else
        const bool again = false;
#endif
        if (again) rep = 1; else { rep = 0; ++ph; }
        if (ph < ph1) { if (ph == 1 && rep == 0) grid.sync(); else xcd_barrier(xb); }
    }
}

extern "C" void kernel_launch(void* const* d_in, const int* in_sizes, int n_in, void* d_out, int out_size, void* d_ws, size_t ws_size, hipStream_t stream) {
    Params p{};
    const float* const* in = (const float* const*)d_in;
    p.x = in[0]; p.norm1_g = in[1]; p.w_in = in[2]; p.b_forget = in[3]; p.conv_w = in[4]; p.conv_b = in[5]; p.ln_g = in[6]; p.ln_b = in[7];
    p.rg_conv_w = in[8]; p.rg_conv_b = in[9]; p.rg_w_r = in[10]; p.rg_b_r = in[11]; p.rg_w_i = in[12]; p.rg_b_i = in[13]; p.rg_lambda = in[14];
    p.w_out = in[15]; p.norm2_g = in[16]; p.wq = in[17]; p.k1 = in[18]; p.k2 = in[19]; p.pu = in[20]; p.pv = in[21]; p.final_g = in[22];
    p.out = (float*)d_out;
    char* w = (char*)d_ws; size_t off = 0;
    auto take = [&](size_t bytes) { char* r = w + off; off += (bytes + 255) & ~(size_t)255; return r; };
    p.WinT = (bf16_t*)take((size_t)2 * NINP * 1024 * 2);
    p.WoutT = (bf16_t*)take((size_t)2 * 1024 * 1024 * 2);
    p.WcT = (bf16_t*)take((size_t)2 * 2048 * 1024 * 2);
    p.U8 = (unsigned char*)take((size_t)2 * 16384 * 1024);
    p.V8 = (unsigned char*)take((size_t)2 * 16384 * 1024);
    p.su = (float*)take((size_t)2 * 16384 * 4);
    p.sv = (float*)take((size_t)2 * 16384 * 4);
    p.ctr = (unsigned*)take(6 * 256 * 4);
    p.bar = (unsigned*)take(XCD_BAR_WORDS * 4);
    p.rstd2 = (float*)take((size_t)T * 4);
    p.xb = (bf16_t*)take((size_t)T * 1024 * 2);
    p.ssqA = (float*)take((size_t)8 * T * 4);
    p.ssqE = (float*)take((size_t)16 * T * 4);
    p.wbuf = (float*)take((size_t)T * 128 * 4);
    p.logf = (float*)take((size_t)T * 8 * 4);
    p.kb = (float*)take((size_t)T * 8 * 4);
    p.Aagg = (float*)take((size_t)4 * 128 * 256 * 4);
    p.Bagg = (float*)take((size_t)4 * 128 * 256 * 4);
    p.experts = (int*)take((size_t)T * 128 * 4);
    p.gates = (float*)take((size_t)T * 128 * 4);
    char* r1 = take(0);
    p.proj = (bf16_t*)take((size_t)T * NIN * 2);
    p.mixed = (bf16_t*)take((size_t)T * 1024 * 2);
    p.hloc = (bf16_t*)take((size_t)T * 256 * 2);
    p.Pc = (bf16_t*)take((size_t)T * 256 * 2);
    p.HP = (unsigned*)p.hloc;
    p.AB = p.Aagg;
    p.scT = (float*)r1;
    p.part = (float*)r1;
    if (off > ws_size) { fprintf(stderr, "workspace too small: need %zu have %zu\n", off, ws_size); }

    static int grid_blocks = 0;
    if (!grid_blocks) {
        int dev = 0, cus = 0, per_cu = 0;
        hipGetDevice(&dev);
        hipDeviceGetAttribute(&cus, hipDeviceAttributeMultiprocessorCount, dev);
        hipOccupancyMaxActiveBlocksPerMultiprocessor(&per_cu, mega_kernel, NTHREADS, 0);
        if (per_cu > 3) per_cu = 3;
        if (per_cu < 1) per_cu = 1;
        grid_blocks = cus * per_cu;
        grid_blocks &= ~7;
    }
    hipMemsetAsync(p.ctr, 0, 6 * 256 * 4 + XCD_BAR_WORDS * 4, stream);
    int ph0 = 0, ph1 = 20;
    void* args[] = {&p, &ph0, &ph1};
    hipError_t e = hipLaunchCooperativeKernel((void*)mega_kernel, dim3(grid_blocks), dim3(NTHREADS), args, 0, stream);
    if (e != hipSuccess) fprintf(stderr, "cooperative launch failed: %s (grid %d)\n", hipGetErrorString(e), grid_blocks);
}
```

```cpp
#include <hip/hip_runtime.h>
#include <hip/hip_cooperative_groups.h>
#include <cstdint>
#include <cstdio>
namespace cg = cooperative_groups;

typedef unsigned short bf16_t;
typedef short bf16x8 __attribute__((ext_vector_type(8)));
typedef float f32x4 __attribute__((ext_vector_type(4)));
typedef float f32x16 __attribute__((ext_vector_type(16)));
typedef float f32x2 __attribute__((ext_vector_type(2)));
typedef __bf16 v2bf __attribute__((ext_vector_type(2)));
typedef unsigned u32x4 __attribute__((ext_vector_type(4)));
typedef int i32x4 __attribute__((ext_vector_type(4)));

constexpr int T = 32768, D = 1024, S = 8192;
constexpr int NIN = 2568, NINP = 2688;
constexpr int F0 = 1536, C0 = 1544, R0 = 2056, G0 = 2312;
constexpr float EPS = 1e-6f;
constexpr float LOG2E = 1.4426950408889634f;
constexpr int NTHREADS = 256;
constexpr int SMEM_BYTES = 52224;

struct Params {
    const float *x, *norm1_g, *w_in, *b_forget, *conv_w, *conv_b, *ln_g, *ln_b;
    const float *rg_conv_w, *rg_conv_b, *rg_w_r, *rg_b_r, *rg_w_i, *rg_b_i, *rg_lambda;
    const float *w_out, *norm2_g, *wq, *k1, *k2, *pu, *pv, *final_g;
    float* out;
    bf16_t *WinT, *WoutT, *WcT, *proj, *mixed, *hloc, *Pc;
    unsigned* HP; float* AB;
    unsigned char *U8, *V8;
    float *su, *sv;
    float *logf, *kb, *Aagg, *Bagg, *scT, *gates, *rstd2, *part, *wbuf;
    bf16_t* xb;
    float *ssqA, *ssqE;
    int* experts;
    unsigned* ctr; unsigned* bar;
};

__device__ __forceinline__ unsigned pk_bf16(float lo, float hi) { unsigned r; asm("v_cvt_pk_bf16_f32 %0, %1, %2" : "=v"(r) : "v"(lo), "v"(hi)); return r; }
__device__ __forceinline__ bf16_t f2bf(float f) { return (bf16_t)(pk_bf16(f, 0.f) & 0xffffu); }
__device__ __forceinline__ float bf2f(bf16_t b) { return __uint_as_float(((unsigned)b) << 16); }
__device__ __forceinline__ float bflo(unsigned u) { return __uint_as_float(u << 16); }
__device__ __forceinline__ float bfhi(unsigned u) { return __uint_as_float(u & 0xffff0000u); }
__device__ __forceinline__ float sigmoidf_(float x) { return 1.0f / (1.0f + __expf(-x)); }
__device__ __forceinline__ float gelu_tanh(float x) { const float u = 0.7978845608028654f * (x + 0.044715f * x * x * x); return x / (1.0f + __expf(-2.0f * u)); }
__device__ __forceinline__ int get_tid() { int t = threadIdx.x; asm volatile("" : "+v"(t)); return t; }
__device__ __forceinline__ int get_bid() { int b = blockIdx.x; asm volatile("" : "+s"(b)); return b; }
__device__ __forceinline__ float log1p_pos(float x) { return x < 0.0625f ? x * (1.0f - x * (0.5f - x * (0.33333334f - x * (0.25f - x * 0.2f)))) : __logf(1.0f + x); }
__device__ __forceinline__ float neg_expm1_neg(float y) { return y > -0.25f ? -y * (1.0f + 0.5f * y * (1.0f + 0.33333334f * y * (1.0f + 0.25f * y * (1.0f + 0.2f * y * (1.0f + 0.16666667f * y))))) : 1.0f - __expf(y); }
__device__ __forceinline__ float wave_sum(float v) {
#pragma unroll
    for (int o = 32; o >= 1; o >>= 1) v += __shfl_xor(v, o);
    return v;
}

__device__ void prep_transpose(const float* src, int ldn, int nvalid, const float* g, bf16_t* dst, int kt, int nt, char* smem) {
    float* sm = (float*)smem;
    const int tid = get_tid(), col = tid & 63, r0 = tid >> 6;
#pragma unroll 4
    for (int i = 0; i < 16; ++i) {
        const int row = r0 + 4 * i, k = kt * 64 + row, n = nt * 64 + col;
        float v = 0.f;
        if (n < nvalid) { v = src[(size_t)k * ldn + n]; if (g) v *= g[k]; }
        sm[row * 65 + col] = v;
    }
    __syncthreads();
#pragma unroll 4
    for (int i = 0; i < 16; ++i) {
        const int nl = r0 + 4 * i;
        dst[(size_t)(nt * 64 + nl) * 1024 + kt * 64 + col] = f2bf(sm[col * 65 + nl]);
    }
    __syncthreads();
}

__device__ void prep_wc(const Params& p, int l, int item, char* smem) {
    float* sK = (float*)smem;
    float* sW = sK + 64 * 65;
    const int dt = item & 15, jt = (item >> 4) & 1, hp = item >> 5, h = hp >> 1, pp = hp & 1;
    const float* Kp = (pp ? p.k2 : p.k1) + ((size_t)(l * 8 + h) * 128) * 128;
    const float* Wq = p.wq + (size_t)l * 1024 * 2048 + h * 256 + pp * 128;
    const int tid = get_tid(), cl = tid & 63, r0 = tid >> 6, tx = tid & 15, ty = tid >> 4;
    float acc[4][4];
#pragma unroll
    for (int a = 0; a < 4; ++a)
#pragma unroll
        for (int b = 0; b < 4; ++b) acc[a][b] = 0.f;
    for (int ch = 0; ch < 2; ++ch) {
#pragma unroll 4
        for (int i = 0; i < 16; ++i) {
            const int rl = r0 + 4 * i;
            sK[rl * 65 + cl] = Kp[(size_t)(jt * 64 + rl) * 128 + ch * 64 + cl];
            sW[rl * 65 + cl] = Wq[(size_t)(dt * 64 + rl) * 2048 + ch * 64 + cl];
        }
        __syncthreads();
#pragma unroll 8
        for (int c = 0; c < 64; ++c) {
            float kv[4], wv[4];
#pragma unroll
            for (int a = 0; a < 4; ++a) { kv[a] = sK[(ty * 4 + a) * 65 + c]; wv[a] = sW[(tx * 4 + a) * 65 + c]; }
#pragma unroll
            for (int a = 0; a < 4; ++a)
#pragma unroll
                for (int b = 0; b < 4; ++b) acc[a][b] += kv[a] * wv[b];
        }
        __syncthreads();
    }
    const float* g2 = p.norm2_g + l * 1024 + dt * 64 + tx * 4;
    const float g0 = g2[0], g1 = g2[1], g2v = g2[2], g3 = g2[3];
#pragma unroll
    for (int a = 0; a < 4; ++a) {
        const int n = hp * 128 + jt * 64 + ty * 4 + a;
        uint2 w; w.x = pk_bf16(acc[a][0] * g0, acc[a][1] * g1); w.y = pk_bf16(acc[a][2] * g2v, acc[a][3] * g3);
        *(uint2*)(p.WcT + ((size_t)l * 2048 + n) * 1024 + dt * 64 + tx * 4) = w;
    }
}

__device__ void prep_fp8_row(const float* src, unsigned char* dst8, float* scale, int row  , int lane) {
    const float* r = src + (size_t)row * 1024 + lane * 16;
    f32x4 v[4];
#pragma unroll
    for (int i = 0; i < 4; ++i) v[i] = __builtin_nontemporal_load((const f32x4*)(r + 4 * i));
    float am = 0.f;
#pragma unroll
    for (int i = 0; i < 4; ++i) am = fmaxf(am, fmaxf(fmaxf(fabsf(v[i][0]), fabsf(v[i][1])), fmaxf(fabsf(v[i][2]), fabsf(v[i][3]))));
#pragma unroll
    for (int o = 32; o >= 1; o >>= 1) am = fmaxf(am, __shfl_xor(am, o));
    const float sc = am > 0.f ? am * (1.0f / 127.0f) : 1.0f, inv = am > 0.f ? 127.0f / am : 0.0f;
    u32x4 w;
#pragma unroll
    for (int i = 0; i < 4; ++i) {
        const int q0 = __float2int_rn(v[i][0] * inv), q1 = __float2int_rn(v[i][1] * inv), q2 = __float2int_rn(v[i][2] * inv), q3 = __float2int_rn(v[i][3] * inv);
        w[i] = (unsigned)(q0 & 255) | ((unsigned)(q1 & 255) << 8) | ((unsigned)(q2 & 255) << 16) | ((unsigned)q3 << 24);
    }
    const int l = row >> 14, e = row & 16383, x = lane >> 3, c = lane & 7;
    *(u32x4*)(dst8 + ((size_t)(l * 8 + x) * 16384 + e) * 128 + c * 16) = w;
    if (lane == 0) scale[row] = sc;
}

__device__ void prep_x_row(const Params& p, int t, int lane) {
    const float* xr = p.x + (size_t)t * 1024;
    float ss = 0.f;
#pragma unroll
    for (int i = 0; i < 2; ++i) {
        const f32x4 a = *(const f32x4*)(xr + i * 512 + lane * 8), b = *(const f32x4*)(xr + i * 512 + lane * 8 + 4);
        ss += a[0] * a[0] + a[1] * a[1] + a[2] * a[2] + a[3] * a[3] + b[0] * b[0] + b[1] * b[1] + b[2] * b[2] + b[3] * b[3];
        u32x4 w; w.x = pk_bf16(a[0], a[1]); w.y = pk_bf16(a[2], a[3]); w.z = pk_bf16(b[0], b[1]); w.w = pk_bf16(b[2], b[3]);
        *(u32x4*)(p.xb + (size_t)t * 1024 + i * 512 + lane * 8) = w;
    }
    ss = wave_sum(ss);
    if (lane == 0) p.ssqA[t] = ss;
}

__device__ void phase_prep(const Params& p, char* smem) {
    { const int tid = get_tid(); for (int t = get_bid() * 4 + (tid >> 6); t < T; t += gridDim.x * 4) prep_x_row(p, t, tid & 63); }
    for (int it = get_bid(); it < 2880; it += gridDim.x) {
        if (it < 1344) { const int l = it / 672, r = it % 672, kt = r / 42, nt = r % 42;
            prep_transpose(p.w_in + (size_t)l * 1024 * NIN, NIN, NIN, p.norm1_g + l * 1024, p.WinT + (size_t)l * NINP * 1024, kt, nt, smem);
        } else if (it < 1856) { const int j = it - 1344, l = j / 256, r = j % 256, kt = r / 16, nt = r % 16;
            prep_transpose(p.w_out + (size_t)l * 1024 * 1024, 1024, 1024, nullptr, p.WoutT + (size_t)l * 1024 * 1024, kt, nt, smem);
        } else if (it < 2880) { const int j = it - 1856; prep_wc(p, j / 512, j % 512, smem);
        }
    }
}

template <int AF32, int SWAP, class Epi>
__device__ __forceinline__ void gemm_tile(const void* Aptr, const bf16_t* Bt, int tm, int tn, const Epi& epi, char* smem, const float* ssq = nullptr, int nparts = 0) {
    constexpr int K = 1024;
    bf16_t* sA = (bf16_t*)smem;
    bf16_t* sB = sA + 2 * 4096;
    float* sRs = (float*)(smem + 32768);
    const int tid = get_tid(), lane = tid & 63, wid = tid >> 6, wr = wid >> 1, wc = wid & 1, fr = lane & 15, fq = lane >> 4;
    f32x4 acc[4][4];
#pragma unroll
    for (int m = 0; m < 4; ++m)
#pragma unroll
        for (int n = 0; n < 4; ++n) acc[m][n] = (f32x4){0.f, 0.f, 0.f, 0.f};
    float ss[4] = {0.f, 0.f, 0.f, 0.f};
    struct Stage { f32x4 ra[4]; u32x4 rab[2]; u32x4 rb[2]; };
    Stage st0, st1;
    const float* Af = (const float*)Aptr + (size_t)tm * 128 * K;
    const bf16_t* Ab = (const bf16_t*)Aptr + (size_t)tm * 128 * K;
    const bf16_t* Bp = Bt + (size_t)tn * 128 * K;
    auto gload = [&](int kt, Stage& st) {
        if (AF32) {
#pragma unroll
            for (int i = 0; i < 4; ++i) st.ra[i] = *(const f32x4*)(Af + (size_t)((tid >> 3) + 32 * i) * K + kt * 32 + (tid & 7) * 4);
        } else {
#pragma unroll
            for (int i = 0; i < 2; ++i) { const int c = tid + 256 * i; st.rab[i] = *(const u32x4*)(Ab + (size_t)(c >> 2) * K + kt * 32 + (c & 3) * 8); }
        }
#pragma unroll
        for (int i = 0; i < 2; ++i) { const int c = tid + 256 * i; st.rb[i] = *(const u32x4*)(Bp + (size_t)(c >> 2) * K + kt * 32 + (c & 3) * 8); }
    };
    auto sstore = [&](int buf, const Stage& st) {
        if (AF32) {
#pragma unroll
            for (int i = 0; i < 4; ++i) {
                const f32x4 v = st.ra[i];
                ss[i] += v.x * v.x + v.y * v.y + v.z * v.z + v.w * v.w;
                uint2 w; w.x = pk_bf16(v.x, v.y); w.y = pk_bf16(v.z, v.w);
                { const int r = (tid >> 3) + 32 * i, hc = tid & 7; *(uint2*)(sA + buf * 4096 + r * 32 + (((hc >> 1) ^ ((r >> 2) & 3)) * 8) + (hc & 1) * 4) = w; }
            }
        } else {
#pragma unroll
            for (int i = 0; i < 2; ++i) { const int c = tid + 256 * i, r = c >> 2; *(u32x4*)(sA + buf * 4096 + r * 32 + ((c & 3) ^ ((r >> 2) & 3)) * 8) = st.rab[i]; }
        }
#pragma unroll
        for (int i = 0; i < 2; ++i) { const int c = tid + 256 * i, r = c >> 2; *(u32x4*)(sB + buf * 4096 + r * 32 + ((c & 3) ^ ((r >> 2) & 3)) * 8) = st.rb[i]; }
    };
    auto compute = [&](int buf) {
        bf16x8 af[4], bfr[4];
#pragma unroll
        for (int m = 0; m < 4; ++m) { const int r = wr * 64 + m * 16 + fr; af[m] = *(const bf16x8*)(sA + buf * 4096 + r * 32 + (fq ^ ((r >> 2) & 3)) * 8); }
#pragma unroll
        for (int n = 0; n < 4; ++n) { const int r = wc * 64 + (SWAP ? ((fr >> 2) * 16 + n * 4 + (fr & 3)) : (n * 16 + fr)); bfr[n] = *(const bf16x8*)(sB + buf * 4096 + r * 32 + (fq ^ ((r >> 2) & 3)) * 8); }
#pragma unroll
        for (int m = 0; m < 4; ++m)
#pragma unroll
            for (int n = 0; n < 4; ++n)
                acc[m][n] = SWAP ? __builtin_amdgcn_mfma_f32_16x16x32_bf16(bfr[n], af[m], acc[m][n], 0, 0, 0)
                                 : __builtin_amdgcn_mfma_f32_16x16x32_bf16(af[m], bfr[n], acc[m][n], 0, 0, 0);
    };
    if (nparts > 0 && tid < 128) {
        float sq = 0.f;
        for (int q = 0; q < nparts; ++q) sq += ssq[(size_t)q * T + (size_t)tm * 128 + tid];
        sRs[tid] = rsqrtf(sq * (1.0f / 1024.0f) + EPS);
    }
    gload(0, st0); sstore(0, st0); gload(1, st1); __syncthreads();
    for (int kt = 0; kt < 32; kt += 2) {
        gload(min(kt + 2, 31), st0);
        compute(0);
        sstore(1, st1);
        __syncthreads();
        gload(min(kt + 3, 31), st1);
        compute(1);
        if (kt + 2 < 32) sstore(0, st0);
        __syncthreads();
    }
    if (AF32) {
#pragma unroll
        for (int i = 0; i < 4; ++i) {
            float s = ss[i];
            s += __shfl_xor(s, 1); s += __shfl_xor(s, 2); s += __shfl_xor(s, 4);
            if ((tid & 7) == 0) sRs[(tid >> 3) + 32 * i] = rsqrtf(s * (1.0f / 1024.0f) + EPS);
        }
        __syncthreads();
    }
    epi(acc, tm, tn, wr, wc, fr, fq, sRs);
}

__device__ __forceinline__ bool gemm_ticket(unsigned* ctr, int nt, int& tm, int& tn, char* smem) {
    int* sT = (int*)(smem + 32768 + 512);
    const int xcd = get_bid() & 7;
    if (get_tid() == 0) sT[0] = (int)atomicAdd(ctr + xcd * 32, 1u);
    __syncthreads();
    const int j = sT[0];
    if (j >= 32 * nt) return false;
    const int full = nt >> 3, rem = nt & 7;
    int tn_g, tm_g, q;
    if (j < full * 256) { tn_g = j >> 8; const int r = j & 255; tm_g = r >> 6; q = r & 63; }
    else { const int r = j - full * 256; tn_g = full; tm_g = r / (8 * rem); q = r % (8 * rem); }
    tm = ((tm_g * 8 + (q & 7)) * 8) + xcd; tn = tn_g * 8 + (q >> 3); return true;
}


template <class Epi>
__device__ __forceinline__ void gemm_tile64(const bf16_t* A, const bf16_t* Bt, int tm, int tn, const Epi& epi, char* smem, const float* ssq, int nparts) {
    constexpr int K = 1024;
    bf16_t* sA = (bf16_t*)smem;
    bf16_t* sB = sA + 8192;
    float* sRs = (float*)(smem + 32768);
    const int tid = get_tid(), lane = tid & 63, wid = tid >> 6, wr = wid >> 1, wc = wid & 1, fr = lane & 15, fq = lane >> 4;
    f32x4 acc[4][4];
#pragma unroll
    for (int m = 0; m < 4; ++m)
#pragma unroll
        for (int n = 0; n < 4; ++n) acc[m][n] = (f32x4){0.f, 0.f, 0.f, 0.f};
    if (nparts > 0 && tid < 128) {
        float sq = 0.f;
        for (int q = 0; q < nparts; ++q) sq += ssq[(size_t)q * T + (size_t)tm * 128 + tid];
        sRs[tid] = rsqrtf(sq * (1.0f / 1024.0f) + EPS);
    }
    const int lrow = tid >> 3, lc8 = tid & 7;
    const bf16_t* Ap = A + ((size_t)tm * 128 + lrow) * K + lc8 * 8;
    const bf16_t* Bp = Bt + ((size_t)tn * 128 + lrow) * K + lc8 * 8;
    struct Slab { u32x4 a[4], b[4]; };
    auto gload = [&](int kt, Slab& sl) {
#pragma unroll
        for (int i = 0; i < 4; ++i) { sl.a[i] = *(const u32x4*)(Ap + (size_t)(32 * i) * K + kt * 64); sl.b[i] = *(const u32x4*)(Bp + (size_t)(32 * i) * K + kt * 64); }
    };
    auto sstore = [&](const Slab& sl) {
#pragma unroll
        for (int i = 0; i < 4; ++i) {
            const int r = lrow + 32 * i;
            *(u32x4*)(sA + r * 64 + ((lc8 ^ ((r >> 1) & 7)) * 8)) = sl.a[i];
            const int rs = (r & 64) | (((r >> 2) & 3) << 4) | (((r >> 4) & 3) << 2) | (r & 3);
            *(u32x4*)(sB + rs * 64 + ((lc8 ^ ((rs >> 1) & 7)) * 8)) = sl.b[i];
        }
    };
    auto compute = [&]() {
#pragma unroll
        for (int ks = 0; ks < 2; ++ks) {
            bf16x8 af[4], bfr[4];
#pragma unroll
            for (int m = 0; m < 4; ++m) { const int r = wr * 64 + m * 16 + fr; af[m] = *(const bf16x8*)(sA + r * 64 + (((ks * 4 + fq) ^ ((r >> 1) & 7)) * 8)); }
#pragma unroll
            for (int n = 0; n < 4; ++n) { const int r = wc * 64 + n * 16 + fr; bfr[n] = *(const bf16x8*)(sB + r * 64 + (((ks * 4 + fq) ^ ((r >> 1) & 7)) * 8)); }
#pragma unroll
            for (int m = 0; m < 4; ++m)
#pragma unroll
                for (int n = 0; n < 4; ++n) acc[m][n] = __builtin_amdgcn_mfma_f32_16x16x32_bf16(bfr[n], af[m], acc[m][n], 0, 0, 0);
        }
    };
    Slab s0;
    gload(0, s0);
    for (int kt = 0; kt < 16; ++kt) {
        __syncthreads(); sstore(s0); __syncthreads();
        gload(min(kt + 1, 15), s0);
        compute();
    }
    epi(acc, tm, tn, wr, wc, fr, fq, sRs);
}

__device__ __forceinline__ bool gemm_next(int it, int nt, int& tm, int& tn) {
    const int G8 = gridDim.x >> 3;
    const int xcd = get_bid() & 7, slot = get_bid() >> 3;
    const int j = it * G8 + slot;
    if (j >= 32 * nt) return false;
    const int full = nt >> 3, rem = nt & 7;
    int tn_g, tm_g, q;
    if (j < full * 256) { tn_g = j >> 8; const int r = j & 255; tm_g = r >> 6; q = r & 63; }
    else { const int r = j - full * 256; tn_g = full; tm_g = r / (8 * rem); q = r % (8 * rem); }
    tm = ((tm_g * 8 + (q & 7)) * 8) + xcd; tn = tn_g * 8 + (q >> 3); return true;
}

struct EpiInProj {
    const Params* p; int l;
    __device__ __forceinline__ void operator()(const f32x4 (&acc)[4][4], int tm, int tn, int wr, int wc, int fr, int fq, const float* sRs) const {
        const int col0 = tn * 128 + wc * 64 + fq * 16;
#pragma unroll
        for (int m = 0; m < 4; ++m) {
            const int rl = wr * 64 + m * 16 + fr; const float rs = sRs[rl]; const size_t row = (size_t)tm * 128 + rl;
            const f32x4 v0 = acc[m][0] * rs, v1 = acc[m][1] * rs, v2 = acc[m][2] * rs, v3 = acc[m][3] * rs;
            if (col0 == F0) {
                const float* bf = p->b_forget + l * 8;
                f32x4 o0, o1;
#pragma unroll
                for (int j = 0; j < 4; ++j) {
                    const float z0 = v0[j] + bf[j], z1 = v1[j] + bf[4 + j];
                    o0[j] = fminf(z0, 0.f) - log1p_pos(__expf(-fabsf(z0))); o1[j] = fminf(z1, 0.f) - log1p_pos(__expf(-fabsf(z1)));
                }
                *(f32x4*)(p->logf + row * 8) = o0; *(f32x4*)(p->logf + row * 8 + 4) = o1;
            }
            if (col0 + 8 <= NIN) { u32x4 w; w.x = pk_bf16(v0[0], v0[1]); w.y = pk_bf16(v0[2], v0[3]); w.z = pk_bf16(v1[0], v1[1]); w.w = pk_bf16(v1[2], v1[3]); *(u32x4*)(p->proj + row * NIN + col0) = w; }
            if (col0 + 16 <= NIN) { u32x4 w; w.x = pk_bf16(v2[0], v2[1]); w.y = pk_bf16(v2[2], v2[3]); w.z = pk_bf16(v3[0], v3[1]); w.w = pk_bf16(v3[2], v3[3]); *(u32x4*)(p->proj + row * NIN + col0 + 8) = w; }
        }
    }
};

struct EpiOutProj {
    const float* xin; float* xout; bf16_t* xb; float* ssq;
    __device__ __forceinline__ void operator()(const f32x4 (&acc)[4][4], int tm, int tn, int wr, int wc, int fr, int fq, const float*) const {
        const int col0 = tn * 128 + wc * 64 + fq * 16;
#pragma unroll
        for (int m = 0; m < 4; ++m) {
            const size_t row = (size_t)tm * 128 + wr * 64 + m * 16 + fr;
            f32x4 o[4]; float sq = 0.f;
#pragma unroll
            for (int n = 0; n < 4; ++n) {
                o[n] = *(const f32x4*)(xin + row * 1024 + col0 + n * 4) + acc[m][n];
                *(f32x4*)(xout + row * 1024 + col0 + n * 4) = o[n];
                sq += o[n][0] * o[n][0] + o[n][1] * o[n][1] + o[n][2] * o[n][2] + o[n][3] * o[n][3];
            }
            u32x4 w0, w1;
            w0.x = pk_bf16(o[0][0], o[0][1]); w0.y = pk_bf16(o[0][2], o[0][3]); w0.z = pk_bf16(o[1][0], o[1][1]); w0.w = pk_bf16(o[1][2], o[1][3]);
            w1.x = pk_bf16(o[2][0], o[2][1]); w1.y = pk_bf16(o[2][2], o[2][3]); w1.z = pk_bf16(o[3][0], o[3][1]); w1.w = pk_bf16(o[3][2], o[3][3]);
            *(u32x4*)(xb + row * 1024 + col0) = w0; *(u32x4*)(xb + row * 1024 + col0 + 8) = w1;
            sq += __shfl_xor(sq, 16); sq += __shfl_xor(sq, 32);
            if (fq == 0) ssq[(size_t)(tn * 2 + wc) * T + row] = sq;
        }
    }
};

struct EpiScores {
    float* scT; float* rstd2;
    __device__ __forceinline__ void operator()(const f32x4 (&acc)[4][4], int tm, int tn, int wr, int wc, int fr, int fq, const float* sRs) const {
#pragma unroll
        for (int m = 0; m < 4; ++m) {
            const int rl = wr * 64 + m * 16 + fr;
            const float rs = sRs[rl];
            if (tn == 0 && wc == 0 && fq == 0) rstd2[(size_t)tm * 128 + rl] = rs;
#pragma unroll
            for (int n = 0; n < 4; ++n) {
                const int col = tn * 128 + wc * 64 + fq * 16 + n * 4;
                __builtin_nontemporal_store(acc[m][n] * rs, (f32x4*)(scT + (((size_t)(tm * 2 + (rl >> 6)) * 512 + (col >> 2)) * 64 + (rl & 63)) * 4));
            }
        }
    }
};

__device__ void cumsum_item(const Params& p, int bh, char* smem) {
    float* sm = (float*)smem;
    const int b = bh >> 3, h = bh & 7, tid = get_tid(), lane = tid & 63, wid = tid >> 6;
    const float* src = p.logf + ((size_t)b * S + tid * 32) * 8 + h;
    float loc[32]; float run = 0.f;
#pragma unroll
    for (int i = 0; i < 32; ++i) { run += src[i * 8]; loc[i] = run; }
    float incl = run;
#pragma unroll
    for (int o = 1; o < 64; o <<= 1) { const float t = __shfl_up(incl, o); if (lane >= o) incl += t; }
    if (lane == 63) sm[wid] = incl;
    __syncthreads();
    float wbase = 0.f;
    for (int w = 0; w < wid; ++w) wbase += sm[w];
    const float excl = wbase + incl - run;
    float* dst = p.kb + (size_t)bh * S + tid * 32;
#pragma unroll
    for (int i = 0; i < 32; i += 4) {
        float4 o; o.x = -(excl + loc[i]) * LOG2E; o.y = -(excl + loc[i + 1]) * LOG2E; o.z = -(excl + loc[i + 2]) * LOG2E; o.w = -(excl + loc[i + 3]) * LOG2E;
        *(float4*)(dst + i) = o;
    }
    __syncthreads();
}

__device__ void conv_item(const Params& p, int l, int item, char* smem) {
    bf16_t* sG = (bf16_t*)smem;
    float* sY = (float*)(smem + 46 * 256 * 2);
    const int b = item >> 9, tt = item & 511, t0 = tt * 16, tid = get_tid(), lane = tid & 63, wid = tid >> 6;
    const bf16_t* projb = p.proj + (size_t)b * S * NIN;
#pragma unroll
    for (int i = 0; i < 6; ++i) {
        const int task = tid + 256 * i, r = task >> 5, cc = task & 31;
        if (r < 46) {
            const int t = t0 - 30 + r;
            uint4 w = {0u, 0u, 0u, 0u};
            if (t >= 0) {
                const uint4 a = *(const uint4*)(projb + (size_t)t * NIN + C0 + cc * 8);
                const uint4 g = *(const uint4*)(projb + (size_t)t * NIN + C0 + 256 + cc * 8);
                w.x = pk_bf16(bflo(a.x) * sigmoidf_(bflo(g.x)), bfhi(a.x) * sigmoidf_(bfhi(g.x)));
                w.y = pk_bf16(bflo(a.y) * sigmoidf_(bflo(g.y)), bfhi(a.y) * sigmoidf_(bfhi(g.y)));
                w.z = pk_bf16(bflo(a.z) * sigmoidf_(bflo(g.z)), bfhi(a.z) * sigmoidf_(bfhi(g.z)));
                w.w = pk_bf16(bflo(a.w) * sigmoidf_(bflo(g.w)), bfhi(a.w) * sigmoidf_(bfhi(g.w)));
            }
            *(uint4*)(sG + r * 256 + cc * 8) = w;
        }
    }
    float wk[31];
#pragma unroll
    for (int k = 0; k < 31; ++k) wk[k] = p.conv_w[((size_t)l * 31 + k) * 256 + tid];
    const float bias = p.conv_b[l * 256 + tid];
    __syncthreads();
#pragma unroll 1
    for (int tl = 0; tl < 16; ++tl) {
        float y = bias;
#pragma unroll
        for (int k = 0; k < 31; ++k) y += wk[k] * bf2f(sG[(tl + k) * 256 + tid]);
        sY[tl * 256 + tid] = y;
    }
    __syncthreads();
    const float4 g4 = *(const float4*)(p.ln_g + l * 256 + lane * 4), b4 = *(const float4*)(p.ln_b + l * 256 + lane * 4);
#pragma unroll
    for (int j = 0; j < 4; ++j) {
        const int tl = wid * 4 + j;
        const float4 y = *(const float4*)(sY + tl * 256 + lane * 4);
        const float s1 = wave_sum(y.x + y.y + y.z + y.w);
        const float mean = s1 * (1.0f / 256.0f);
        const float dx = y.x - mean, dy = y.y - mean, dz = y.z - mean, dw = y.w - mean;
        const float s2 = wave_sum(dx * dx + dy * dy + dz * dz + dw * dw);
        const float rstd = rsqrtf(s2 * (1.0f / 256.0f) + EPS);
        float o0 = dx * rstd * g4.x + b4.x, o1 = dy * rstd * g4.y + b4.y, o2 = dz * rstd * g4.z + b4.z, o3 = dw * rstd * g4.w + b4.w;
        o0 *= sigmoidf_(o0); o1 *= sigmoidf_(o1); o2 *= sigmoidf_(o2); o3 *= sigmoidf_(o3);
        uint2 w; w.x = pk_bf16(o0, o1); w.y = pk_bf16(o2, o3);
        *(uint2*)(p.mixed + ((size_t)b * S + t0 + tl) * 1024 + 512 + lane * 4) = w;
    }
    __syncthreads();
}

__device__ void rnn1_item(const Params& p, int l, int item, char* smem) {
    float* sX = (float*)smem;
    float* sWr = sX + 67 * 64;
    float* sWi = sWr + 4096;
    float* sAg = sWi + 4096;
    const int hb = item & 3, j = (item >> 2) & 127, b = item >> 9, t0 = j * 64;
    const int tid = get_tid(), c = tid & 63, q = tid >> 6;
    const bf16_t* projb = p.proj + (size_t)b * S * NIN;
#pragma unroll
    for (int i = 0; i < 3; ++i) {
        const int r = (tid >> 3) + 32 * i, c8 = tid & 7;
        if (r < 67) {
            const int t = t0 - 3 + r;
            uint4 a = {0u, 0u, 0u, 0u};
            if (t >= 0) a = *(const uint4*)(projb + (size_t)t * NIN + R0 + hb * 64 + c8 * 8);
            float* d = sX + r * 64 + c8 * 8;
            d[0] = bflo(a.x); d[1] = bfhi(a.x); d[2] = bflo(a.y); d[3] = bfhi(a.y); d[4] = bflo(a.z); d[5] = bfhi(a.z); d[6] = bflo(a.w); d[7] = bfhi(a.w);
        }
    }
    {
        const float* wr = p.rg_w_r + ((size_t)l * 4 + hb) * 4096; const float* wi = p.rg_w_i + ((size_t)l * 4 + hb) * 4096;
#pragma unroll
        for (int i = 0; i < 16; ++i) { sWr[tid + 256 * i] = wr[tid + 256 * i]; sWi[tid + 256 * i] = wi[tid + 256 * i]; }
    }
    const int ch = hb * 64 + c;
    float cw[4];
#pragma unroll
    for (int k = 0; k < 4; ++k) cw[k] = p.rg_conv_w[((size_t)l * 4 + k) * 256 + ch];
    const float cb = p.rg_conv_b[l * 256 + ch];
    __syncthreads();
    float xc[16];
#pragma unroll
    for (int i = 0; i < 16; ++i) {
        const int tl = q * 16 + i;
        xc[i] = cb + cw[0] * sX[(tl + 0) * 64 + c] + cw[1] * sX[(tl + 1) * 64 + c] + cw[2] * sX[(tl + 2) * 64 + c] + cw[3] * sX[(tl + 3) * 64 + c];
    }
    __syncthreads();
#pragma unroll
    for (int i = 0; i < 16; ++i) sX[(q * 16 + i) * 64 + c] = xc[i];
    __syncthreads();
    float ar[16], ai[16];
#pragma unroll
    for (int i = 0; i < 16; ++i) { ar[i] = 0.f; ai[i] = 0.f; }
    for (int k = 0; k < 64; ++k) {
        const float wrv = sWr[k * 64 + c], wiv = sWi[k * 64 + c];
#pragma unroll
        for (int i = 0; i < 16; ++i) { const float xv = sX[(q * 16 + i) * 64 + k]; ar[i] += xv * wrv; ai[i] += xv * wiv; }
    }
    const float br = p.rg_b_r[l * 256 + ch], bi = p.rg_b_i[l * 256 + ch];
    const float lam = p.rg_lambda[l * 256 + ch];
    const float sp = log1p_pos(__expf(-lam));
    float hl[16], Pl[16];
    float hrun = 0.f, prun = 1.f;
#pragma unroll
    for (int i = 0; i < 16; ++i) {
        const float r = sigmoidf_(ar[i] + br), ig = sigmoidf_(ai[i] + bi);
        const float log_a = -8.0f * r * sp;
        const float a = __expf(log_a);
        const float mult = sqrtf(neg_expm1_neg(2.0f * log_a));
        const float bt = mult * ig * xc[i];
        hrun = a * hrun + bt; prun *= a;
        hl[i] = hrun; Pl[i] = prun;
    }
    sAg[q * 64 + c] = prun; sAg[256 + q * 64 + c] = hrun;
    __syncthreads();
    float carry = 0.f, pprev = 1.f;
    for (int qq = 0; qq < q; ++qq) { const float pe = sAg[qq * 64 + c], he = sAg[256 + qq * 64 + c]; carry = pe * carry + he; pprev *= pe; }
    unsigned* sHP = (unsigned*)sWr;
#pragma unroll
    for (int i = 0; i < 16; ++i) sHP[(q * 16 + i) * 64 + c] = pk_bf16(hl[i] + Pl[i] * carry, Pl[i] * pprev);
    if (q == 3) {
        const size_t o = ((size_t)b * 128 + j) * 256 + ch;
        *(f32x2*)(p.AB + 2 * o) = (f32x2){Pl[15] * pprev, hl[15] + Pl[15] * carry};
    }
    __syncthreads();
#pragma unroll
    for (int i = 0; i < 4; ++i) {
        const int tl = (tid >> 4) + 16 * i, c4 = (tid & 15) * 4;
        *(u32x4*)(p.HP + ((size_t)b * S + t0 + tl) * 256 + hb * 64 + c4) = *(const u32x4*)(sHP + tl * 64 + c4);
    }
    __syncthreads();
}

constexpr int ATT_BUF = 18688;
__device__ void attn_item(const Params& p, int s_idx, char* smem) {
    const int qb = 63 - (s_idx >> 5), bh = s_idx & 31, b = bh >> 3, h = bh & 7;
    const int tid = get_tid(), lane = tid & 63, wid = tid >> 6, ql = lane & 31, hh = lane >> 5;
    const int qrow = qb * 128 + wid * 32 + ql;
    const bf16_t* projb = p.proj + (size_t)b * S * NIN;
    bf16x8 qf[4];
#pragma unroll
    for (int kk = 0; kk < 4; ++kk) qf[kk] = *(const bf16x8*)(projb + (size_t)qrow * NIN + h * 64 + kk * 16 + hh * 8);
    f32x16 O0, O1;
#pragma unroll
    for (int i = 0; i < 16; ++i) { O0[i] = 0.f; O1[i] = 0.f; }
    float mrun = -INFINITY, lsum = 0.f;
    const int nkt = qb * 2 + 2;
    const int wave_last = (qb * 128 + wid * 32 + 31) >> 6;
    const int wave_q0 = qb * 128 + wid * 32;
    const float sc = 0.125f * LOG2E;
    struct KV { u32x4 rk[2], rv[2]; float rkb; };
    KV sa;
    auto gload = [&](int kt, KV& st) {
#pragma unroll
        for (int i = 0; i < 2; ++i) {
            const int c = tid + 256 * i, key = c >> 3, dc = c & 7;
            const bf16_t* src = projb + (size_t)(kt * 64 + key) * NIN + h * 64 + dc * 8;
            st.rk[i] = *(const u32x4*)(src + 512);
            const int keyv = c & 63, dcv = c >> 6;
            st.rv[i] = *(const u32x4*)(projb + (size_t)(kt * 64 + keyv) * NIN + 1024 + h * 64 + dcv * 8);
        }
        st.rkb = p.kb[(size_t)bh * S + kt * 64 + (tid & 63)];
    };
    auto sstore = [&](int buf, const KV& st) {
        bf16_t* sK = (bf16_t*)(smem + buf * ATT_BUF); bf16_t* sVt = sK + 64 * 72; float* sKb = (float*)(smem + buf * ATT_BUF + 18432);
#pragma unroll
        for (int i = 0; i < 2; ++i) {
            const int c = tid + 256 * i, key = c >> 3, dc = c & 7;
            *(u32x4*)(sK + key * 72 + dc * 8) = st.rk[i];
            const unsigned w0 = st.rv[i].x, w1 = st.rv[i].y, w2 = st.rv[i].z, w3 = st.rv[i].w;
            bf16_t* d = sVt + ((c >> 6) * 8) * 72 + (c & 63);
            d[0 * 72] = (bf16_t)(w0 & 0xffffu); d[1 * 72] = (bf16_t)(w0 >> 16);
            d[2 * 72] = (bf16_t)(w1 & 0xffffu); d[3 * 72] = (bf16_t)(w1 >> 16);
            d[4 * 72] = (bf16_t)(w2 & 0xffffu); d[5 * 72] = (bf16_t)(w2 >> 16);
            d[6 * 72] = (bf16_t)(w3 & 0xffffu); d[7 * 72] = (bf16_t)(w3 >> 16);
        }
        if (tid < 64) sKb[tid] = st.rkb;
    };
    const int pr = (ql & 0x13) | ((ql & 4) << 1) | ((ql & 8) >> 1);
    auto compute = [&](int kt, int buf) {
        if (kt <= wave_last) {
            const bf16_t* sK = (const bf16_t*)(smem + buf * ATT_BUF); const bf16_t* sVt = sK + 64 * 72; const float* sKb = (const float*)(smem + buf * ATT_BUF + 18432);
            f32x16 S0, S1;
#pragma unroll
            for (int i = 0; i < 16; ++i) { S0[i] = 0.f; S1[i] = 0.f; }
#pragma unroll
            for (int kk = 0; kk < 4; ++kk) {
                const bf16x8 k0 = *(const bf16x8*)(sK + pr * 72 + kk * 16 + hh * 8);
                const bf16x8 k1 = *(const bf16x8*)(sK + (32 + pr) * 72 + kk * 16 + hh * 8);
                S0 = __builtin_amdgcn_mfma_f32_32x32x16_bf16(k0, qf[kk], S0, 0, 0, 0);
                S1 = __builtin_amdgcn_mfma_f32_32x32x16_bf16(k1, qf[kk], S1, 0, 0, 0);
            }
            float sv[32];
#pragma unroll
            for (int g = 0; g < 4; ++g) {
                const int kbase = (g >> 1) * 32 + (g & 1) * 16 + 8 * hh;
                const float4 b0 = *(const float4*)(sKb + kbase), b1 = *(const float4*)(sKb + kbase + 4);
                const int o = (g & 1) * 8;
                if (g >> 1) {
                    sv[g * 8 + 0] = S1[o + 0] * sc + b0.x; sv[g * 8 + 1] = S1[o + 1] * sc + b0.y; sv[g * 8 + 2] = S1[o + 2] * sc + b0.z; sv[g * 8 + 3] = S1[o + 3] * sc + b0.w;
                    sv[g * 8 + 4] = S1[o + 4] * sc + b1.x; sv[g * 8 + 5] = S1[o + 5] * sc + b1.y; sv[g * 8 + 6] = S1[o + 6] * sc + b1.z; sv[g * 8 + 7] = S1[o + 7] * sc + b1.w;
                } else {
                    sv[g * 8 + 0] = S0[o + 0] * sc + b0.x; sv[g * 8 + 1] = S0[o + 1] * sc + b0.y; sv[g * 8 + 2] = S0[o + 2] * sc + b0.z; sv[g * 8 + 3] = S0[o + 3] * sc + b0.w;
                    sv[g * 8 + 4] = S0[o + 4] * sc + b1.x; sv[g * 8 + 5] = S0[o + 5] * sc + b1.y; sv[g * 8 + 6] = S0[o + 6] * sc + b1.z; sv[g * 8 + 7] = S0[o + 7] * sc + b1.w;
                }
            }
            if (kt * 64 + 63 > wave_q0) {
#pragma unroll
                for (int g = 0; g < 4; ++g) {
                    const int kbase = kt * 64 + (g >> 1) * 32 + (g & 1) * 16 + 8 * hh;
#pragma unroll
                    for (int e = 0; e < 8; ++e) if (kbase + e > qrow) sv[g * 8 + e] = -INFINITY;
                }
            }
            float mx = sv[0];
#pragma unroll
            for (int i = 1; i < 32; ++i) mx = fmaxf(mx, sv[i]);
            mx = fmaxf(mx, __shfl_xor(mx, 32));
            const float mnew = fmaxf(mrun, mx);
            const float alpha = __builtin_amdgcn_exp2f(mrun - mnew);
            mrun = mnew;
            float psum = 0.f;
#pragma unroll
            for (int i = 0; i < 32; ++i) { sv[i] = __builtin_amdgcn_exp2f(sv[i] - mnew); psum += sv[i]; }
            lsum = lsum * alpha + psum;
#pragma unroll
            for (int i = 0; i < 16; ++i) { O0[i] *= alpha; O1[i] *= alpha; }
#pragma unroll
            for (int g = 0; g < 4; ++g) {
                bf16x8 pf;
                {
                    const unsigned u0 = pk_bf16(sv[g * 8 + 0], sv[g * 8 + 1]), u1 = pk_bf16(sv[g * 8 + 2], sv[g * 8 + 3]);
                    const unsigned u2 = pk_bf16(sv[g * 8 + 4], sv[g * 8 + 5]), u3 = pk_bf16(sv[g * 8 + 6], sv[g * 8 + 7]);
                    const uint4 uu = {u0, u1, u2, u3};
                    pf = __builtin_bit_cast(bf16x8, uu);
                }
                const int koff = (g >> 1) * 32 + (g & 1) * 16 + 8 * hh;
                const bf16x8 v0 = *(const bf16x8*)(sVt + ql * 72 + koff);
                const bf16x8 v1 = *(const bf16x8*)(sVt + (32 + ql) * 72 + koff);
                O0 = __builtin_amdgcn_mfma_f32_32x32x16_bf16(v0, pf, O0, 0, 0, 0);
                O1 = __builtin_amdgcn_mfma_f32_32x32x16_bf16(v1, pf, O1, 0, 0, 0);
            }
        }
    };
    gload(0, sa); sstore(0, sa); __syncthreads();
    for (int kt = 0; kt < nkt; kt += 2) {
        gload(kt + 1, sa);
        compute(kt, 0);
        sstore(1, sa);
        __syncthreads();
        gload(min(kt + 2, nkt - 1), sa);
        compute(kt + 1, 1);
        if (kt + 2 < nkt) sstore(0, sa);
        __syncthreads();
    }
    const float ltot = lsum + __shfl_xor(lsum, 32);
    const float inv = 1.0f / ltot;
    bf16_t* orow = p.mixed + ((size_t)b * S + qrow) * 1024 + h * 64;
#pragma unroll
    for (int g = 0; g < 4; ++g) {
        uint2 w0, w1;
        w0.x = pk_bf16(O0[g * 4 + 0] * inv, O0[g * 4 + 1] * inv); w0.y = pk_bf16(O0[g * 4 + 2] * inv, O0[g * 4 + 3] * inv);
        w1.x = pk_bf16(O1[g * 4 + 0] * inv, O1[g * 4 + 1] * inv); w1.y = pk_bf16(O1[g * 4 + 2] * inv, O1[g * 4 + 3] * inv);
        *(uint2*)(orow + 8 * g + 4 * hh) = w0;
        *(uint2*)(orow + 32 + 8 * g + 4 * hh) = w1;
    }
}

__device__ void rnn2_item(const Params& p, int item, char* smem) {
    float* sCarry = (float*)smem;
    float* sSeg = sCarry + 64;
    const int hb = item & 3, j = (item >> 2) & 127, b = item >> 9, t0 = j * 64;
    const int tid = get_tid();
    {
        const int w = tid >> 6, c = tid & 63, j0 = (j * w) >> 2, j1 = (j * (w + 1)) >> 2;
        float a = 1.f, bb = 0.f;
        const f32x2* ab = (const f32x2*)p.AB + ((size_t)b * 128) * 256 + hb * 64 + c;
#pragma unroll 16
        for (int jp = j0; jp < j1; ++jp) { const f32x2 v = ab[(size_t)jp * 256]; bb = v.x * bb + v.y; a *= v.x; }
        sSeg[(w * 2 + 0) * 64 + c] = a; sSeg[(w * 2 + 1) * 64 + c] = bb;
    }
    __syncthreads();
    if (tid < 64) {
        float carry = sSeg[1 * 64 + tid];
#pragma unroll
        for (int w = 1; w < 4; ++w) carry = sSeg[(w * 2) * 64 + tid] * carry + sSeg[(w * 2 + 1) * 64 + tid];
        sCarry[tid] = carry;
    }
    __syncthreads();
    const int cc = tid & 7;
    const f32x4 ca = *(const f32x4*)(sCarry + cc * 8), cb = *(const f32x4*)(sCarry + cc * 8 + 4);
    const float cr[8] = {ca[0], ca[1], ca[2], ca[3], cb[0], cb[1], cb[2], cb[3]};
#pragma unroll
    for (int i = 0; i < 2; ++i) {
        const size_t t = (size_t)b * S + t0 + (tid >> 3) + 32 * i;
        const u32x4 h0 = *(const u32x4*)(p.HP + t * 256 + hb * 64 + cc * 8), h1 = *(const u32x4*)(p.HP + t * 256 + hb * 64 + cc * 8 + 4);
        const u32x4 gt = *(const u32x4*)(p.proj + t * NIN + G0 + hb * 64 + cc * 8);
        const unsigned hp[8] = {h0.x, h0.y, h0.z, h0.w, h1.x, h1.y, h1.z, h1.w};
        const unsigned gw[4] = {gt.x, gt.y, gt.z, gt.w};
        float o[8];
#pragma unroll
        for (int e = 0; e < 8; ++e) {
            const float hfull = bflo(hp[e]) + bfhi(hp[e]) * cr[e];
            const float gate = (e & 1) ? bfhi(gw[e >> 1]) : bflo(gw[e >> 1]);
            o[e] = hfull * gelu_tanh(gate);
        }
        u32x4 w; w.x = pk_bf16(o[0], o[1]); w.y = pk_bf16(o[2], o[3]); w.z = pk_bf16(o[4], o[5]); w.w = pk_bf16(o[6], o[7]);
        *(u32x4*)(p.mixed + t * 1024 + 768 + hb * 64 + cc * 8) = w;
    }
    __syncthreads();
}

__device__ __forceinline__ unsigned f2sort(float f) { const unsigned u = __float_as_uint(f); return (u & 0x80000000u) ? ~u : (u | 0x80000000u); }
__device__ __forceinline__ float sort2f(unsigned k) { const unsigned u = (k & 0x80000000u) ? (k & 0x7fffffffu) : ~k; return __uint_as_float(u); }

__device__ __forceinline__ void sort16_desc(unsigned (&v)[16]) {
#pragma unroll
    for (int k = 2; k <= 16; k <<= 1)
#pragma unroll
        for (int j = k >> 1; j > 0; j >>= 1)
#pragma unroll
            for (int i = 0; i < 16; ++i) {
                const int l = i ^ j;
                if (l > i) {
                    const unsigned a = v[i], b = v[l];
                    const bool desc = ((i & k) == 0) || (k == 16);
                    v[i] = desc ? max(a, b) : min(a, b);
                    v[l] = desc ? min(a, b) : max(a, b);
                }
            }
}
__device__ __forceinline__ void merge16_desc(unsigned (&top)[16], const unsigned (&c)[16]) {
#pragma unroll
    for (int i = 0; i < 16; ++i) top[i] = max(top[i], c[15 - i]);
#pragma unroll
    for (int j = 8; j > 0; j >>= 1)
#pragma unroll
        for (int i = 0; i < 16; ++i) {
            const int l = i ^ j;
            if (l > i) { const unsigned a = top[i], b = top[l]; top[i] = max(a, b); top[l] = min(a, b); }
        }
}

__device__ void topk_item(const Params& p, int wi, char* smem) {
    const int tid = get_tid(), lane = tid & 63, wid = tid >> 6;
    int* sIdx = (int*)smem + wid * 2048;
    const int head = wi & 7, tg = wi >> 3, t = tg * 64 + lane;
    float vals[2][16];
    {
        const f32x4* base = (const f32x4*)p.scT + ((size_t)tg * 512 + head * 64) * 64 + lane;
        f32x4 bufA[8], bufB[8];
        auto ldc = [&](int ch, f32x4 (&buf)[8]) {
#pragma unroll
            for (int q = 0; q < 8; ++q) buf[q] = __builtin_nontemporal_load(base + (ch * 8 + q) * 64);
        };
        unsigned top[16];
        auto ins = [&](int ch, const f32x4 (&buf)[8]) {
#pragma unroll
            for (int grp = 0; grp < 2; ++grp) {
                unsigned c[16];
#pragma unroll
                for (int q = 0; q < 4; ++q)
#pragma unroll
                    for (int e = 0; e < 4; ++e)
                        c[q * 4 + e] = (f2sort(buf[grp * 4 + q][e]) & ~127u) | (unsigned)(127 - ((ch & 3) * 32 + (grp * 4 + q) * 4 + e));
                sort16_desc(c);
                if ((ch & 3) == 0 && grp == 0) {
#pragma unroll
                    for (int i = 0; i < 16; ++i) top[i] = c[i];
                } else merge16_desc(top, c);
            }
        };
        auto fin = [&](int half) {
#pragma unroll
            for (int i = 0; i < 16; ++i) { vals[half][i] = sort2f(top[i] & ~127u); sIdx[(half * 16 + i) * 64 + lane] = 127 - (int)(top[i] & 127u); }
        };
        ldc(0, bufA); ldc(1, bufB);
        ins(0, bufA); ldc(2, bufA);
        ins(1, bufB); ldc(3, bufB);
        ins(2, bufA); ldc(4, bufA);
        ins(3, bufB); fin(0); ldc(5, bufB);
        ins(4, bufA); ldc(6, bufA);
        ins(5, bufB); ldc(7, bufB);
        ins(6, bufA);
        ins(7, bufB); fin(1);
    }
#define CKEY(i, j) ((f2sort(vals[0][i] + vals[1][j]) & ~255u) | (unsigned)(255 - ((i) * 16 + (j))))
    unsigned top[16];
#pragma unroll
    for (int j = 0; j < 16; ++j) top[j] = CKEY(0, j);
    {
        unsigned ca[16] = {CKEY(1, 0), CKEY(1, 1), CKEY(1, 2), CKEY(1, 3), CKEY(1, 4), CKEY(1, 5), CKEY(1, 6), CKEY(1, 7), CKEY(2, 0), CKEY(2, 1), CKEY(2, 2), CKEY(2, 3), CKEY(2, 4), CKEY(3, 0), CKEY(3, 1), CKEY(3, 2)};
        sort16_desc(ca); merge16_desc(top, ca);
        unsigned cb[16] = {CKEY(3, 3), CKEY(4, 0), CKEY(4, 1), CKEY(4, 2), CKEY(5, 0), CKEY(5, 1), CKEY(6, 0), CKEY(6, 1), CKEY(7, 0), CKEY(7, 1), CKEY(8, 0), CKEY(9, 0), CKEY(10, 0), CKEY(11, 0), CKEY(12, 0), CKEY(13, 0)};
        sort16_desc(cb); merge16_desc(top, cb);
        unsigned y = CKEY(14, 0);
#pragma unroll
        for (int q = 0; q < 16; ++q) { const unsigned hi = max(top[q], y); y = min(top[q], y); top[q] = hi; }
        y = CKEY(15, 0);
#pragma unroll
        for (int q = 0; q < 16; ++q) { const unsigned hi = max(top[q], y); y = min(top[q], y); top[q] = hi; }
    }
#undef CKEY
    float g[16]; float gs = 0.f;
    const float mx = sort2f(top[0] & ~255u);
    int ex[16];
#pragma unroll
    for (int i = 0; i < 16; ++i) {
        g[i] = __expf(sort2f(top[i] & ~255u) - mx); gs += g[i];
        const int ci = 255 - (int)(top[i] & 255u);
        const int e1 = sIdx[(ci >> 4) * 64 + lane], e2 = sIdx[(16 + (ci & 15)) * 64 + lane];
        ex[i] = e1 * 128 + e2;
    }
    const float ginv = 1.0f / gs;
    int* ed = p.experts + (size_t)t * 128 + head * 16; float* gd = p.gates + (size_t)t * 128 + head * 16;
#pragma unroll
    for (int i = 0; i < 16; i += 4) {
        *(int4*)(ed + i) = make_int4(ex[i], ex[i + 1], ex[i + 2], ex[i + 3]);
        *(float4*)(gd + i) = make_float4(g[i] * ginv, g[i + 1] * ginv, g[i + 2] * ginv, g[i + 3] * ginv);
    }
}


constexpr int PEER_LDS_WAVE = 9472;
__device__ __forceinline__ float wave_max(float v) {
#pragma unroll
    for (int o = 32; o >= 1; o >>= 1) v = fmaxf(v, __shfl_xor(v, o));
    return v;
}
__device__ __forceinline__ void peer_u_phase(const Params& p, int l, int x, int wq, int nwq, int lane, int wid, char* smem) {
    const int g = lane >> 3, c = lane & 7, hl = lane >> 5, l32 = lane & 31;
    const int nb = (T / 8 - wq + nwq - 1) / nwq, ntok = nb * 8;
    int* sIds = (int*)(smem + wid * PEER_LDS_WAVE); unsigned char* sXq = (unsigned char*)(sIds + 1024); float* sSh = (float*)(sXq + 1024); float* sPart = sSh + 8;
    const float* ggp = p.norm2_g + l * 1024 + x * 128 + 4 * l32;
    const unsigned char* Ut = p.U8 + ((size_t)(l * 8 + x) * 16384) * 128;
    struct Meta { i32x4 id[4]; f32x4 xv[4]; float rs; };
    auto tok = [&](int k) { const int kk = k < ntok ? k : 0; return ((kk >> 3) * nwq + wq) * 8 + (kk & 7); };
    auto load_meta = [&](int b, Meta& m) {
#pragma unroll
        for (int jj = 0; jj < 4; ++jj) m.id[jj] = *(const i32x4*)(p.experts + (size_t)tok(b * 8 + 2 * jj + hl) * 128 + 4 * l32);
    };
    auto load_x = [&](int b, Meta& m) {
#pragma unroll
        for (int jj = 0; jj < 4; ++jj) m.xv[jj] = *(const f32x4*)(p.out + (size_t)tok(b * 8 + 2 * jj + hl) * 1024 + x * 128 + 4 * l32);
        m.rs = p.rstd2[tok(b * 8 + (lane & 7))];
    };
    auto store_meta = [&](const Meta& m) {
        const f32x4 gg = *(const f32x4*)ggp;
#pragma unroll
        for (int jj = 0; jj < 4; ++jj) {
            const int j = 2 * jj + hl;
            *(i32x4*)(sIds + j * 128 + 4 * l32) = m.id[jj];
            const float rs = __shfl(m.rs, j);
            const f32x4 h = m.xv[jj] * gg * rs;
            float am = fmaxf(fmaxf(fabsf(h[0]), fabsf(h[1])), fmaxf(fabsf(h[2]), fabsf(h[3])));
#pragma unroll
            for (int o = 16; o >= 1; o >>= 1) am = fmaxf(am, __shfl_xor(am, o));
            const float inv = am > 0.f ? 127.0f / am : 0.0f;
            const int q0 = __float2int_rn(h[0] * inv), q1 = __float2int_rn(h[1] * inv), q2 = __float2int_rn(h[2] * inv), q3 = __float2int_rn(h[3] * inv);
            *(unsigned*)(sXq + j * 128 + 4 * l32) = (unsigned)(q0 & 255) | ((unsigned)(q1 & 255) << 8) | ((unsigned)(q2 & 255) << 16) | ((unsigned)q3 << 24);
            if (l32 == 0) sSh[j] = am * (1.0f / 127.0f);
        }
    };
    auto issue = [&](int u, u32x4 (&rows)[8]) {
        const int* ip = sIds + (u >> 1) * 128 + g * 16 + (u & 1) * 8;
        const int4 a = *(const int4*)ip, b = *(const int4*)(ip + 4);
        const int e[8] = {a.x, a.y, a.z, a.w, b.x, b.y, b.z, b.w};
#pragma unroll
        for (int s = 0; s < 8; ++s) rows[s] = *(const u32x4*)(Ut + (unsigned)(e[s] * 128 + c * 16));
    };
    auto compute = [&](int u, const u32x4 (&rows)[8]) {
        const int j = u >> 1;
        const float sh = sSh[j];
        const u32x4 hq = *(const u32x4*)(sXq + j * 128 + c * 16);
        int part[8];
#pragma unroll
        for (int s = 0; s < 8; ++s) {
            int d = __builtin_amdgcn_sdot4((int)rows[s][0], (int)hq[0], 0, false);
            d = __builtin_amdgcn_sdot4((int)rows[s][1], (int)hq[1], d, false);
            d = __builtin_amdgcn_sdot4((int)rows[s][2], (int)hq[2], d, false);
            part[s] = __builtin_amdgcn_sdot4((int)rows[s][3], (int)hq[3], d, false);
        }
#pragma unroll
        for (int o = 4, n = 8; o >= 1; o >>= 1, n >>= 1) {
            const bool up = (lane & o) != 0;
#pragma unroll
            for (int i = 0; i < n / 2; ++i) {
                int lo = part[i], hi = part[i + n / 2];
                asm volatile("" : "+v"(lo), "+v"(hi));
                const int send = up ? lo : hi, keep = up ? hi : lo;
                part[i] = keep + __shfl_xor(send, o);
            }
        }
        sPart[j * 128 + g * 16 + (u & 1) * 8 + c] = (float)part[0] * sh;
    };
    Meta m; load_meta(0, m); load_x(0, m);
    for (int b = 0; b < nb; ++b) {
        __builtin_amdgcn_wave_barrier();
        store_meta(m);
        __builtin_amdgcn_wave_barrier();
        load_meta(min(b + 1, nb - 1), m);
        u32x4 rA[8], rB[8];
        issue(0, rA);
#pragma unroll
        for (int u = 0; u < 16; u += 2) {
            issue(u + 1, rB);
            compute(u, rA);
            if (u + 2 < 16) issue(u + 2, rA);
            if (u == 8) load_x(min(b + 1, nb - 1), m);
            compute(u + 1, rB);
        }
        __builtin_amdgcn_wave_barrier();
#pragma unroll
        for (int jj = 0; jj < 4; ++jj) {
            const int j = 2 * jj + hl, k = b * 8 + j;
            const f32x4 v = *(const f32x4*)(sPart + j * 128 + 4 * l32);
            if (k < ntok) __builtin_nontemporal_store(v, (f32x4*)(p.part + ((size_t)x * T + tok(k)) * 128 + 4 * l32));
        }
    }
}

__device__ __forceinline__ void peer_w_phase(const Params& p, int l) {
    const int tid = get_tid();
    for (size_t i = ((size_t)get_bid() * NTHREADS + tid) * 4; i < (size_t)T * 128; i += (size_t)gridDim.x * NTHREADS * 4) {
        f32x4 hs = __builtin_nontemporal_load((const f32x4*)(p.part + i));
#pragma unroll
        for (int xx = 1; xx < 8; ++xx) hs += __builtin_nontemporal_load((const f32x4*)(p.part + (size_t)xx * T * 128 + i));
        const int4 e = *(const int4*)(p.experts + i);
        const f32x4 gt = *(const f32x4*)(p.gates + i);
        const float* su = p.su + l * 16384; const float* sv = p.sv + l * 16384;
        f32x4 w;
        w[0] = gt[0] * gelu_tanh(hs[0] * su[e.x]) * sv[e.x]; w[1] = gt[1] * gelu_tanh(hs[1] * su[e.y]) * sv[e.y];
        w[2] = gt[2] * gelu_tanh(hs[2] * su[e.z]) * sv[e.z]; w[3] = gt[3] * gelu_tanh(hs[3] * su[e.w]) * sv[e.w];
        *(f32x4*)(p.wbuf + i) = w;
    }
}

__device__ __forceinline__ void peer_v_phase(const Params& p, int l, int x, int wq, int nwq, int lane, int wid, char* smem) {
    const int g = lane >> 3, c = lane & 7, hl = lane >> 5, l32 = lane & 31;
    const int nb = (T / 8 - wq + nwq - 1) / nwq, ntok = nb * 8;
    int* sIds = (int*)(smem + wid * PEER_LDS_WAVE); unsigned char* sWq = (unsigned char*)(sIds + 1024); float* sSw = (float*)(sWq + 1024); float* sOld = sSw + 8;
    const unsigned char* Vt = p.V8 + ((size_t)(l * 8 + x) * 16384) * 128;
    const int ocol = c * 16 + 4 * (g >> 1);
    struct Meta { i32x4 id[4]; f32x4 wv[4]; };
    auto tok = [&](int k) { const int kk = k < ntok ? k : 0; return ((kk >> 3) * nwq + wq) * 8 + (kk & 7); };
    auto load_meta = [&](int b, Meta& m) {
#pragma unroll
        for (int jj = 0; jj < 4; ++jj) {
            const int t = tok(b * 8 + 2 * jj + hl);
            m.id[jj] = *(const i32x4*)(p.experts + (size_t)t * 128 + 4 * l32);
            m.wv[jj] = *(const f32x4*)(p.wbuf + (size_t)t * 128 + 4 * l32);
        }
    };
    auto store_meta = [&](const Meta& m) {
#pragma unroll
        for (int jj = 0; jj < 4; ++jj) {
            const int j = 2 * jj + hl;
            *(i32x4*)(sIds + j * 128 + 4 * l32) = m.id[jj];
            const f32x4 w = m.wv[jj];
            float am = fmaxf(fmaxf(fabsf(w[0]), fabsf(w[1])), fmaxf(fabsf(w[2]), fabsf(w[3])));
#pragma unroll
            for (int o = 16; o >= 1; o >>= 1) am = fmaxf(am, __shfl_xor(am, o));
            const float inv = am > 0.f ? 127.0f / am : 0.0f;
            const int q0 = __float2int_rn(w[0] * inv), q1 = __float2int_rn(w[1] * inv), q2 = __float2int_rn(w[2] * inv), q3 = __float2int_rn(w[3] * inv);
            *(unsigned*)(sWq + j * 128 + 4 * l32) = (unsigned)(q0 & 255) | ((unsigned)(q1 & 255) << 8) | ((unsigned)(q2 & 255) << 16) | ((unsigned)q3 << 24);
            if (l32 == 0) sSw[j] = am * (1.0f / 127.0f);
        }
    };
    auto issue = [&](int u, u32x4 (&rows)[8]) {
        const int* ip = sIds + (u >> 1) * 128 + g * 16 + (u & 1) * 8;
        const int4 a = *(const int4*)ip, b = *(const int4*)(ip + 4);
        const int e[8] = {a.x, a.y, a.z, a.w, b.x, b.y, b.z, b.w};
#pragma unroll
        for (int s = 0; s < 8; ++s) rows[s] = *(const u32x4*)(Vt + (unsigned)(e[s] * 128 + c * 16));
    };
    int acc[16];
    f32x4 oldv;
    auto compute = [&](int u, const u32x4 (&rows)[8], int kbase) {
        const int j = u >> 1;
        if ((u & 1) == 0) {
#pragma unroll
            for (int i = 0; i < 16; ++i) acc[i] = 0;
            oldv = *(const f32x4*)(p.out + (size_t)tok(kbase + j) * 1024 + x * 128 + ocol);
        }
        const uint2 wq2 = *(const uint2*)(sWq + j * 128 + g * 16 + (u & 1) * 8);
#pragma unroll
        for (int hgrp = 0; hgrp < 2; ++hgrp) {
            const int wq4 = (int)(hgrp ? wq2.y : wq2.x);
#pragma unroll
            for (int q = 0; q < 4; ++q) {
                const unsigned r0 = rows[hgrp * 4 + 0][q], r1 = rows[hgrp * 4 + 1][q], r2 = rows[hgrp * 4 + 2][q], r3 = rows[hgrp * 4 + 3][q];
                const unsigned a = __builtin_amdgcn_perm(r1, r0, 0x05010400u), b = __builtin_amdgcn_perm(r1, r0, 0x07030602u);
                const unsigned cc = __builtin_amdgcn_perm(r3, r2, 0x05010400u), d = __builtin_amdgcn_perm(r3, r2, 0x07030602u);
                const unsigned c0 = __builtin_amdgcn_perm(cc, a, 0x05040100u), c1 = __builtin_amdgcn_perm(cc, a, 0x07060302u);
                const unsigned c2 = __builtin_amdgcn_perm(d, b, 0x05040100u), c3 = __builtin_amdgcn_perm(d, b, 0x07060302u);
                acc[4 * q + 0] = __builtin_amdgcn_sdot4((int)c0, wq4, acc[4 * q + 0], false);
                acc[4 * q + 1] = __builtin_amdgcn_sdot4((int)c1, wq4, acc[4 * q + 1], false);
                acc[4 * q + 2] = __builtin_amdgcn_sdot4((int)c2, wq4, acc[4 * q + 2], false);
                acc[4 * q + 3] = __builtin_amdgcn_sdot4((int)c3, wq4, acc[4 * q + 3], false);
            }
        }
        if (u & 1) {
            int part[16];
#pragma unroll
            for (int i = 0; i < 16; ++i) part[i] = acc[i];
#pragma unroll
            for (int o = 32, n = 16; o >= 16; o >>= 1, n >>= 1) {
                const bool up = (lane & o) != 0;
#pragma unroll
                for (int i = 0; i < n / 2; ++i) {
                    int lo = part[i], hi = part[i + n / 2];
                    asm volatile("" : "+v"(lo), "+v"(hi));
                    const int send = up ? lo : hi, keep = up ? hi : lo;
                    part[i] = keep + __shfl_xor(send, o);
                }
            }
#pragma unroll
            for (int i = 0; i < 4; ++i) part[i] += __shfl_xor(part[i], 8);
            const float sw = sSw[j];
            const int k = kbase + j;
            float sq = 0.f;
            if (k < ntok && (g & 1) == 0) {
                f32x4 o = oldv;
                o[0] += (float)part[0] * sw; o[1] += (float)part[1] * sw; o[2] += (float)part[2] * sw; o[3] += (float)part[3] * sw;
                const size_t oi = (size_t)tok(k) * 1024 + x * 128 + ocol;
                *(f32x4*)(p.out + oi) = o;
                if (l == 0) {
                    uint2 wb; wb.x = pk_bf16(o[0], o[1]); wb.y = pk_bf16(o[2], o[3]);
                    *(uint2*)(p.xb + oi) = wb;
                    sq = o[0] * o[0] + o[1] * o[1] + o[2] * o[2] + o[3] * o[3];
                }
            }
            if (l == 0) {
                sq = wave_sum(sq);
                if (k < ntok && lane == 0) p.ssqA[(size_t)x * T + tok(k)] = sq;
            }
        }
    };
    Meta m; load_meta(0, m);
    for (int b = 0; b < nb; ++b) {
        __builtin_amdgcn_wave_barrier();
        store_meta(m);
        __builtin_amdgcn_wave_barrier();
        load_meta(min(b + 1, nb - 1), m);
        u32x4 rA[8], rB[8];
        issue(0, rA);
#pragma unroll
        for (int u = 0; u < 16; u += 2) {
            issue(u + 1, rB);
            compute(u, rA, b * 8);
            if (u + 2 < 16) issue(u + 2, rA);
            compute(u + 1, rB, b * 8);
        }
    }
}

__device__ __forceinline__ void final_norm_token(const Params& p, int t, int lane) {
    float* xr = p.out + (size_t)t * 1024;
    f32x4 v[4];
#pragma unroll
    for (int i = 0; i < 4; ++i) v[i] = *(const f32x4*)(xr + i * 256 + lane * 4);
    float ss = 0.f;
#pragma unroll
    for (int i = 0; i < 4; ++i) ss += v[i][0] * v[i][0] + v[i][1] * v[i][1] + v[i][2] * v[i][2] + v[i][3] * v[i][3];
    ss = wave_sum(ss);
    const float r = rsqrtf(ss * (1.0f / 1024.0f) + EPS);
#pragma unroll
    for (int i = 0; i < 4; ++i) { const f32x4 gg = *(const f32x4*)(p.final_g + i * 256 + lane * 4); *(f32x4*)(xr + i * 256 + lane * 4) = v[i] * r * gg; }
}


#define XB_TMO      128
#define XB_XCNT(j)  (256  + 64 * (j))
#define XB_XSUB(j)  (1280 + 64 * (j))
#define XB_XGEN(j)  (2304 + 64 * (j))
#define XB_TOP      3328
#define XB_TOPGEN   3392
#define XCD_BAR_WORDS 3456
#define XB_SPIN_CAP (1u << 22)
#define LAS __attribute__((address_space(3)))
__device__ __forceinline__ unsigned xb_ld(unsigned* p)              { return __hip_atomic_load(p, __ATOMIC_RELAXED, __HIP_MEMORY_SCOPE_AGENT); }
__device__ __forceinline__ unsigned xb_add(unsigned* p, unsigned v) { return __hip_atomic_fetch_add(p, v, __ATOMIC_RELAXED, __HIP_MEMORY_SCOPE_AGENT); }
__device__ __forceinline__ unsigned xb_xcc_id() { return (unsigned)__builtin_amdgcn_s_getreg((3 << 11) | 20) & 0xFu; }
#define XB_SPIN(cond, bar) do { unsigned _sp = 0; while (cond) { __builtin_amdgcn_s_sleep(1); \
    if ((++_sp & 255u) == 0u) { if (xb_ld(&(bar)[XB_TMO])) break; if (_sp > XB_SPIN_CAP) { atomicAdd(&(bar)[XB_TMO], 1u); break; } } } } while (0)
struct XcdBarrier { unsigned* bar; unsigned x; volatile LAS unsigned* st; };
__device__ __forceinline__ XcdBarrier xcd_barrier_post(unsigned* bar, volatile LAS unsigned* st) {
    XcdBarrier b; b.bar = bar; b.x = xb_xcc_id(); b.st = st;
    if (threadIdx.x == 0) (void)xb_add(&bar[XB_XCNT(b.x)], 1u);
    return b;
}
__device__ __forceinline__ void xcd_barrier_complete(unsigned* bar, unsigned x, unsigned& nloc, unsigned& nx) {
    const unsigned G = gridDim.x * gridDim.y * gridDim.z;
    unsigned sum, cnt, mine, sp = 0u;
    for (;;) {
        sum = 0u; cnt = 0u; mine = 0u;
#pragma unroll
        for (unsigned j = 0; j < 16; ++j) { const unsigned c = xb_ld(&bar[XB_XCNT(j)]); sum += c; cnt += (c > 0u) ? 1u : 0u; mine = (j == x) ? c : mine; }
        if (sum == G) break;
        __builtin_amdgcn_s_sleep(1);
        if ((++sp & 255u) == 0u) { if (xb_ld(&bar[XB_TMO])) break; if (sp > XB_SPIN_CAP) { atomicAdd(&bar[XB_TMO], 1u); break; } }
    }
    nloc = mine > 0u ? mine : 1u; nx = cnt > 0u ? cnt : 1u;
}
__device__ __forceinline__ void xcd_barrier(const XcdBarrier& b) {
    asm volatile("s_waitcnt vmcnt(0)" ::: "memory");
    __syncthreads();
    if (threadIdx.x == 0) {
        unsigned* bar = b.bar;
        __builtin_amdgcn_s_waitcnt(0);
        unsigned nloc = b.st[0], nx = b.st[1];
        if (nloc == 0u) { xcd_barrier_complete(bar, b.x, nloc, nx); b.st[0] = nloc; b.st[1] = nx; }
        const unsigned old = xb_add(&bar[XB_XSUB(b.x)], 1u);
        const unsigned gen = old / nloc;
        if (old + 1u == (gen + 1u) * nloc) {
            __builtin_amdgcn_fence(__ATOMIC_RELEASE, "agent");
            asm volatile("s_waitcnt vmcnt(0)" ::: "memory");
            const unsigned og = xb_add(&bar[XB_TOP], 1u);
            const unsigned tg = og / nx;
            if (og + 1u == (tg + 1u) * nx) xb_add(&bar[XB_TOPGEN], 1u);
            else XB_SPIN(xb_ld(&bar[XB_TOPGEN]) == tg, bar);
            __builtin_amdgcn_fence(__ATOMIC_ACQUIRE, "agent");
            xb_add(&bar[XB_XGEN(b.x)], 1u);
            asm volatile("s_waitcnt vmcnt(0)" ::: "memory");
        } else {
            XB_SPIN(xb_ld(&bar[XB_XGEN(b.x)]) == gen, bar);
            __builtin_amdgcn_fence(__ATOMIC_ACQUIRE, "agent");
            asm volatile("s_waitcnt vmcnt(0)" ::: "memory");
        }
    }
    __syncthreads();
}

__device__ void run_phase(const Params& p, int ph, char* smem) {
    if (ph == 0) { phase_prep(p, smem); return; }
    if (ph == 19) {
        const int tid = get_tid(), wid = __builtin_amdgcn_readfirstlane(tid >> 6), lane = tid & 63;
        for (int t = get_bid() * 4 + wid; t < T; t += gridDim.x * 4) final_norm_token(p, t, lane);
        return;
    }
    const int l = (ph - 1) / 9, s = (ph - 1) % 9;
    if (s == 0) {
        EpiInProj epi{&p, l};
        int tm, tn;
        while (gemm_ticket(p.ctr + (l * 3 + 0) * 256, 21, tm, tn, smem)) gemm_tile64(p.xb, p.WinT + (size_t)l * NINP * 1024, tm, tn, epi, smem, p.ssqA, l == 0 ? 1 : 8);
    } else if (s == 1) {
        for (int it = get_bid(); it < 32; it += gridDim.x) cumsum_item(p, it, smem);
        for (int it = gridDim.x - 1 - get_bid(); it < 2048; it += gridDim.x) conv_item(p, l, it, smem);
        for (int it = get_bid(); it < 2048; it += gridDim.x) rnn1_item(p, l, it, smem);
    } else if (s == 2) {
        const bool quant_first = ((((unsigned)get_bid() >> 8) ^ (unsigned)get_bid()) & 1u) != 0u;
        const int G = gridDim.x, nr = (2048 + G - 1) / G;
        const int nq = (16384 + G - 1) / G, qper = (nq + nr - 1) / nr;
        auto do_quant = [&](int chunk) {
            const int qt = get_tid();
            for (int i = chunk * qper; i < (chunk + 1) * qper && i < nq; ++i) {
                const int j = i * G + get_bid();
                if (j < 16384) {
                    const int row = (j & 8191) * 4 + (qt >> 6);
                    if (j < 8192) prep_fp8_row(p.pu, p.U8, p.su, row, qt & 63); else prep_fp8_row(p.pv, p.V8, p.sv, row, qt & 63);
                }
            }
        };
        for (int r = 0; r < nr; ++r) {
            if (l == 0 && quant_first) do_quant(r);
            const int pos = (r & 1) ? (G - 1 - get_bid()) : get_bid();
            const int si = r * G + pos;
            if (si < 2048) attn_item(p, si, smem);
            if (l == 0 && !quant_first) do_quant(r);
        }
        for (int it = get_bid(); it < 2048; it += gridDim.x) rnn2_item(p, it, smem);
    } else if (s == 3) {
        EpiOutProj epi{l == 0 ? p.x : (const float*)p.out, p.out, p.xb, p.ssqE};
        int tm, tn;
        while (gemm_ticket(p.ctr + (l * 3 + 1) * 256, 8, tm, tn, smem)) gemm_tile64(p.mixed, p.WoutT + (size_t)l * 1024 * 1024, tm, tn, epi, smem, nullptr, 0);
    } else if (s == 4) {
        EpiScores epi{p.scT, p.rstd2};
        int tm, tn;
        while (gemm_ticket(p.ctr + (l * 3 + 2) * 256, 16, tm, tn, smem)) gemm_tile64(p.xb, p.WcT + (size_t)l * 2048 * 1024, tm, tn, epi, smem, p.ssqE, 16);
    } else if (s == 5) {
        const int wid = get_tid() >> 6;
        for (int it = get_bid(); it < 1024; it += gridDim.x) topk_item(p, it * 4 + wid, smem);
    } else {
        if (s == 7) { peer_w_phase(p, l); return; }
        const int tid = get_tid(), wu = __builtin_amdgcn_readfirstlane(tid >> 6), lane = tid & 63;
        const int x = get_bid() & 7, wq = (get_bid() >> 3) * 4 + wu, nwq = (gridDim.x >> 3) * 4;
        if (s == 6) peer_u_phase(p, l, x, wq, nwq, lane, wu, smem);
        else        peer_v_phase(p, l, x, wq, nwq, lane, wu, smem);
    }
}

__global__ void __launch_bounds__(NTHREADS, 3) mega_kernel(Params p, int ph0, int ph1) {
    __shared__ __attribute__((aligned(16))) char smem[SMEM_BYTES];
    __shared__ __attribute__((aligned(16))) unsigned xb_st[4];
    cg::grid_group grid = cg::this_grid();
    if (threadIdx.x < 4) xb_st[threadIdx.x] = 0u;
    __syncthreads();
    const XcdBarrier xb = xcd_barrier_post(p.bar, (volatile LAS unsigned*)xb_st);
    int ph = ph0, rep = 0;
    while (ph < ph1) {
        run_phase(p, ph, smem);
#ifdef REP_MASK
        const bool again = rep == 0 && ph >= 1 && ph <= 18 && ((REP_MASK >> ((ph - 1) % 9)) & 1);
#else
        const bool again = false;
#endif
        if (again) rep = 1; else { rep = 0; ++ph; }
        if (ph < ph1) { if (ph == 1 && rep == 0) grid.sync(); else xcd_barrier(xb); }
    }
}

extern "C" void kernel_launch(void* const* d_in, const int* in_sizes, int n_in, void* d_out, int out_size, void* d_ws, size_t ws_size, hipStream_t stream) {
    Params p{};
    const float* const* in = (const float* const*)d_in;
    p.x = in[0]; p.norm1_g = in[1]; p.w_in = in[2]; p.b_forget = in[3]; p.conv_w = in[4]; p.conv_b = in[5]; p.ln_g = in[6]; p.ln_b = in[7];
    p.rg_conv_w = in[8]; p.rg_conv_b = in[9]; p.rg_w_r = in[10]; p.rg_b_r = in[11]; p.rg_w_i = in[12]; p.rg_b_i = in[13]; p.rg_lambda = in[14];
    p.w_out = in[15]; p.norm2_g = in[16]; p.wq = in[17]; p.k1 = in[18]; p.k2 = in[19]; p.pu = in[20]; p.pv = in[21]; p.final_g = in[22];
    p.out = (float*)d_out;
    char* w = (char*)d_ws; size_t off = 0;
    auto take = [&](size_t bytes) { char* r = w + off; off += (bytes + 255) & ~(size_t)255; return r; };
    p.WinT = (bf16_t*)take((size_t)2 * NINP * 1024 * 2);
    p.WoutT = (bf16_t*)take((size_t)2 * 1024 * 1024 * 2);
    p.WcT = (bf16_t*)take((size_t)2 * 2048 * 1024 * 2);
    p.U8 = (unsigned char*)take((size_t)2 * 16384 * 1024);
    p.V8 = (unsigned char*)take((size_t)2 * 16384 * 1024);
    p.su = (float*)take((size_t)2 * 16384 * 4);
    p.sv = (float*)take((size_t)2 * 16384 * 4);
    p.ctr = (unsigned*)take(6 * 256 * 4);
    p.bar = (unsigned*)take(XCD_BAR_WORDS * 4);
    p.rstd2 = (float*)take((size_t)T * 4);
    p.xb = (bf16_t*)take((size_t)T * 1024 * 2);
    p.ssqA = (float*)take((size_t)8 * T * 4);
    p.ssqE = (float*)take((size_t)16 * T * 4);
    p.wbuf = (float*)take((size_t)T * 128 * 4);
    p.logf = (float*)take((size_t)T * 8 * 4);
    p.kb = (float*)take((size_t)T * 8 * 4);
    p.Aagg = (float*)take((size_t)4 * 128 * 256 * 4);
    p.Bagg = (float*)take((size_t)4 * 128 * 256 * 4);
    p.experts = (int*)take((size_t)T * 128 * 4);
    p.gates = (float*)take((size_t)T * 128 * 4);
    char* r1 = take(0);
    p.proj = (bf16_t*)take((size_t)T * NIN * 2);
    p.mixed = (bf16_t*)take((size_t)T * 1024 * 2);
    p.hloc = (bf16_t*)take((size_t)T * 256 * 2);
    p.Pc = (bf16_t*)take((size_t)T * 256 * 2);
    p.HP = (unsigned*)p.hloc;
    p.AB = p.Aagg;
    p.scT = (float*)r1;
    p.part = (float*)r1;
    if (off > ws_size) { fprintf(stderr, "workspace too small: need %zu have %zu\n", off, ws_size); }

    static int grid_blocks = 0;
    if (!grid_blocks) {
        int dev = 0, cus = 0, per_cu = 0;
        hipGetDevice(&dev);
        hipDeviceGetAttribute(&cus, hipDeviceAttributeMultiprocessorCount, dev);
        hipOccupancyMaxActiveBlocksPerMultiprocessor(&per_cu, mega_kernel, NTHREADS, 0);
        if (per_cu > 3) per_cu = 3;
        if (per_cu < 1) per_cu = 1;
        grid_blocks = cus * per_cu;
        grid_blocks &= ~7;
    }
    hipMemsetAsync(p.ctr, 0, 6 * 256 * 4 + XCD_BAR_WORDS * 4, stream);
    int ph0 = 0, ph1 = 20;
    void* args[] = {&p, &ph0, &ph1};
    hipError_t e = hipLaunchCooperativeKernel((void*)mega_kernel, dim3(grid_blocks), dim3(NTHREADS), args, 0, stream);
    if (e != hipSuccess) fprintf(stderr, "cooperative launch failed: %s (grid %d)\n", hipGetErrorString(e), grid_blocks);
}
```
